# Optimizing an MI355X kernel written in HIP

```python
import jax, jax.numpy as jnp
from jax import lax
import numpy as np

D_MODEL = 1024
BATCH = 16
SEQ = 2048
DEPTH = 2

CHUNK = 64
Q_BLOCK = 128
PLE_DIM = 256
D_FF = 2816
EPS = 1e-6
LB_FLOOR = 1e-30
MLA_HEADS = 8
MLA_NOPE = 64
MLA_ROPE = 32
MLA_V = 64
MLA_Q_LORA = 384
MLA_KV_LORA = 256
ROPE_BASE = 10000.0
SB_HEADS = 8
SB_HEAD_DIM = 64
HG_HEADS = 4
HG_KEY = 128
HG_VAL = 128
HG_SUB = 16
N_BRANCH = 3

MLA_WIDTH = MLA_HEADS * MLA_V
SB_WIDTH = SB_HEADS * SB_HEAD_DIM
HG_KEY_WIDTH = HG_HEADS * HG_KEY
HG_VAL_WIDTH = HG_HEADS * HG_VAL
IN_SPLITS = (MLA_Q_LORA, MLA_KV_LORA, MLA_ROPE,
             SB_WIDTH, SB_WIDTH, SB_WIDTH,
             HG_KEY_WIDTH, HG_KEY_WIDTH, HG_VAL_WIDTH, HG_VAL_WIDTH,
             N_BRANCH * D_MODEL)
IN_WIDTH = sum(IN_SPLITS)

kernel_name = "hybrid_mla_stickbreak_hgrn2_macaron"


def rms_norm(x, w):
    x32 = x.astype(jnp.float32)
    y = x32 * lax.rsqrt(jnp.mean(x32 * x32, axis=-1, keepdims=True) + EPS)
    return (y * w.astype(jnp.float32)).astype(x.dtype)


def split_cols(t, sizes):
    out, start = [], 0
    for n in sizes:
        out.append(t[..., start:start + n])
        start += n
    return out


def swiglu(x, w_in, w_out):
    g, up = jnp.split(x @ w_in, 2, axis=-1)
    return (jax.nn.silu(g) * up) @ w_out


def rope_tables(positions):
    half = MLA_ROPE // 2
    inv = ROPE_BASE ** (-jnp.arange(half, dtype=jnp.float32) / half)
    ang = positions.astype(jnp.float32)[..., None] * inv
    return jnp.cos(ang)[:, :, None, :], jnp.sin(ang)[:, :, None, :]


def apply_rope(x, cos, sin):
    half = MLA_ROPE // 2
    x32 = x.astype(jnp.float32)
    x1, x2 = x32[..., :half], x32[..., half:]
    return jnp.concatenate([x1 * cos - x2 * sin, x2 * cos + x1 * sin], axis=-1).astype(x.dtype)


def mla_attention(c_q, c_kv, k_rope, q_norm, w_uq, kv_norm, w_ukv, cos, sin):
    B, S, _ = c_q.shape
    q = (rms_norm(c_q, q_norm) @ w_uq).reshape(B, S, MLA_HEADS, MLA_NOPE + MLA_ROPE)
    q_nope, q_rope = q[..., :MLA_NOPE], apply_rope(q[..., MLA_NOPE:], cos, sin)
    kv = (rms_norm(c_kv, kv_norm) @ w_ukv).reshape(B, S, MLA_HEADS, MLA_NOPE + MLA_V)
    k_nope, v = kv[..., :MLA_NOPE], kv[..., MLA_NOPE:]
    k_r = apply_rope(k_rope[:, :, None, :], cos, sin)[:, :, 0, :]
    scale = (MLA_NOPE + MLA_ROPE) ** -0.5
    chunk_id = jnp.arange(S) // CHUNK
    outs = []
    for q0 in range(0, S, Q_BLOCK):
        q1 = q0 + Q_BLOCK
        s = (jnp.einsum('bqhd,bkhd->bhqk', q_nope[:, q0:q1], k_nope[:, :q1])
             + jnp.einsum('bqhr,bkr->bhqk', q_rope[:, q0:q1], k_r[:, :q1]))
        s = s.astype(jnp.float32) * scale
        mask = chunk_id[q0:q1, None] >= chunk_id[None, :q1]
        pr = jax.nn.softmax(jnp.where(mask, s, -jnp.inf), axis=-1).astype(v.dtype)
        outs.append(jnp.einsum('bhqk,bkhd->bqhd', pr, v[:, :q1]))
    return jnp.concatenate(outs, axis=1).reshape(B, S, MLA_WIDTH)


def stick_breaking_attention(q, k, v):
    B, S, _ = q.shape
    q = q.reshape(B, S, SB_HEADS, SB_HEAD_DIM)
    k = k.reshape(B, S, SB_HEADS, SB_HEAD_DIM)
    v = v.reshape(B, S, SB_HEADS, SB_HEAD_DIM)
    scale = SB_HEAD_DIM ** -0.5
    pos = jnp.arange(S)
    outs = []
    for q0 in range(0, S, Q_BLOCK):
        q1 = q0 + Q_BLOCK
        z = jnp.einsum('bqhd,bkhd->bhqk', q[:, q0:q1], k[:, :q1]).astype(jnp.float32) * scale
        mask = pos[None, :q1] < pos[q0:q1, None]
        log_beta = jax.nn.log_sigmoid(z)
        log_keep = jnp.where(mask, jax.nn.log_sigmoid(-z), 0.0)
        log_rest = lax.cumsum(log_keep, axis=3, reverse=True) - log_keep
        a = jnp.where(mask, jnp.exp(jnp.minimum(log_beta + log_rest, 0.0)), 0.0).astype(v.dtype)
        outs.append(jnp.einsum('bhqk,bkhd->bqhd', a, v[:, :q1]))
    return jnp.concatenate(outs, axis=1).reshape(B, S, SB_WIDTH)


def hgrn2_recurrence(q_raw, f_raw, i_in, g_raw, lb, norm_w):
    B, S, _ = q_raw.shape
    N = S // CHUNK
    NS = CHUNK // HG_SUB
    xf = f_raw.astype(jnp.float32)
    lb = jnp.clip(lb.astype(jnp.float32), 0.0, 1.0 - 1e-6)
    log_f = jnp.logaddexp(jnp.log(jnp.maximum(lb, LB_FLOOR)), jnp.log1p(-lb) + jax.nn.log_sigmoid(xf))
    log_f = jnp.minimum(log_f, 0.0)
    k = (1.0 - lb) * jax.nn.sigmoid(-xf)
    q = jax.nn.silu(q_raw.astype(jnp.float32))
    v = i_in.astype(jnp.float32)

    def to_chunks(t, d):
        return t.reshape(B, N, CHUNK, HG_HEADS, d).transpose(0, 3, 1, 2, 4)

    q, k, log_f = to_chunks(q, HG_KEY), to_chunks(k, HG_KEY), to_chunks(log_f, HG_KEY)
    v = to_chunks(v, HG_VAL)
    b = jnp.cumsum(log_f, axis=3)

    b_ref = jnp.concatenate([jnp.zeros_like(b[:, :, :, :1]),
                             b[:, :, :, HG_SUB - 1:CHUNK - 1:HG_SUB]], axis=3)
    b_sub = b.reshape(B, HG_HEADS, N, NS, HG_SUB, HG_KEY)
    qf = q.reshape(B, HG_HEADS, N, NS, HG_SUB, HG_KEY) * jnp.exp(b_sub - b_ref[:, :, :, :, None, :])
    s_idx = jnp.arange(CHUNK)
    valid = s_idx[None, :] < ((jnp.arange(NS) + 1) * HG_SUB)[:, None]
    expo = jnp.where(valid[:, :, None], b_ref[:, :, :, :, None, :] - b[:, :, :, None, :, :], -jnp.inf)
    kf = k[:, :, :, None] * jnp.exp(expo)
    a = jnp.einsum('bhnilk,bhnisk->bhnils', qf, kf)
    t_idx = jnp.arange(CHUNK).reshape(NS, HG_SUB)
    causal = s_idx[None, None, :] <= t_idx[:, :, None]
    a = jnp.where(causal, a, 0.0)
    o_intra = jnp.einsum('bhnils,bhnsv->bhnilv', a, v).reshape(B, HG_HEADS, N, CHUNK, HG_VAL)

    b_last = b[:, :, :, -1, :]
    qd = q * jnp.exp(b)
    kd = k * jnp.exp(b_last[:, :, :, None, :] - b)
    decay = jnp.exp(b_last)

    def step(state, xs):
        qd_n, kd_n, v_n, decay_n = xs
        o_n = jnp.einsum('bhck,bhkv->bhcv', qd_n, state)
        state = decay_n[..., None] * state + jnp.einsum('bhck,bhcv->bhkv', kd_n, v_n)
        return state, o_n

    xs = (jnp.moveaxis(qd, 2, 0), jnp.moveaxis(kd, 2, 0), jnp.moveaxis(v, 2, 0), jnp.moveaxis(decay, 2, 0))
    state0 = jnp.zeros((B, HG_HEADS, HG_KEY, HG_VAL), jnp.float32)
    _, o_inter = lax.scan(step, state0, xs)
    o = o_intra + jnp.moveaxis(o_inter, 0, 2)
    o = o.transpose(0, 2, 3, 1, 4).reshape(B, S, HG_HEADS, HG_VAL)
    o = o * lax.rsqrt(jnp.mean(o * o, axis=-1, keepdims=True) + EPS)
    o = o * norm_w.astype(jnp.float32).reshape(HG_HEADS, HG_VAL)
    o = o.reshape(B, S, HG_VAL_WIDTH) * jax.nn.silu(g_raw.astype(jnp.float32))
    return o.astype(q_raw.dtype)


def setup_inputs(seed: int = 0) -> dict:
    key = jax.random.key(seed)
    ks = jax.random.split(key, 32)
    f32 = jnp.float32

    def w(k, shape, fan_in):
        return jax.random.normal(k, shape, f32) * (fan_in ** -0.5)

    def gain(k, shape):
        return 1.0 + 0.05 * jax.random.normal(k, shape, f32)

    x = jax.random.normal(ks[0], (BATCH, SEQ, D_MODEL), f32)
    p = jax.random.normal(ks[1], (DEPTH, BATCH, SEQ, PLE_DIM), f32)
    offsets = jax.random.randint(ks[2], (BATCH, 1), 0, 64) * CHUNK
    positions = (offsets + jnp.arange(SEQ, dtype=jnp.int32)[None, :]).astype(jnp.int32)
    return {
        "x": x,
        "p": p,
        "positions": positions,
        "ffn_a_norm": gain(ks[3], (DEPTH, D_MODEL)),
        "ffn_a_w_in": w(ks[4], (DEPTH, D_MODEL, 2 * D_FF), D_MODEL),
        "ffn_a_w_out": w(ks[5], (DEPTH, D_FF, D_MODEL), D_FF),
        "mix_norm": gain(ks[6], (DEPTH, D_MODEL)),
        "w_in": w(ks[7], (DEPTH, D_MODEL, IN_WIDTH), D_MODEL),
        "mla_q_norm": gain(ks[8], (DEPTH, MLA_Q_LORA)),
        "mla_w_uq": w(ks[9], (DEPTH, MLA_Q_LORA, MLA_HEADS * (MLA_NOPE + MLA_ROPE)), MLA_Q_LORA),
        "mla_kv_norm": gain(ks[10], (DEPTH, MLA_KV_LORA)),
        "mla_w_ukv": w(ks[11], (DEPTH, MLA_KV_LORA, MLA_HEADS * (MLA_NOPE + MLA_V)), MLA_KV_LORA),
        "hgrn_lower_bounds": 0.5 * jax.random.normal(ks[12], (DEPTH, HG_KEY_WIDTH), f32),
        "hgrn_out_norm": gain(ks[13], (DEPTH, HG_VAL_WIDTH)),
        "w_br_mla": w(ks[14], (DEPTH, MLA_WIDTH, D_MODEL), MLA_WIDTH),
        "w_br_sb": w(ks[15], (DEPTH, SB_WIDTH, D_MODEL), SB_WIDTH),
        "w_br_hgrn": w(ks[16], (DEPTH, HG_VAL_WIDTH, D_MODEL), HG_VAL_WIDTH),
        "w_out": w(ks[17], (DEPTH, D_MODEL, D_MODEL), D_MODEL),
        "ffn_b_norm": gain(ks[18], (DEPTH, D_MODEL)),
        "ffn_b_w_in": w(ks[19], (DEPTH, D_MODEL, 2 * D_FF), D_MODEL),
        "ffn_b_w_out": w(ks[20], (DEPTH, D_FF, D_MODEL), D_FF),
        "ple_norm": gain(ks[21], (DEPTH, D_MODEL)),
        "w_ple_gate": w(ks[22], (DEPTH, D_MODEL, D_MODEL), D_MODEL),
        "w_ple_proj": w(ks[23], (DEPTH, PLE_DIM, D_MODEL), PLE_DIM),
        "final_norm": gain(ks[24], (D_MODEL,)),
    }


def reference(x, p, positions, ffn_a_norm, ffn_a_w_in, ffn_a_w_out, mix_norm, w_in,
              mla_q_norm, mla_w_uq, mla_kv_norm, mla_w_ukv, hgrn_lower_bounds, hgrn_out_norm,
              w_br_mla, w_br_sb, w_br_hgrn, w_out, ffn_b_norm, ffn_b_w_in, ffn_b_w_out,
              ple_norm, w_ple_gate, w_ple_proj, final_norm):
    B, S, D = x.shape
    cos, sin = rope_tables(positions)
    lb_sm = jax.nn.softmax(hgrn_lower_bounds.astype(jnp.float32), axis=0)
    lb_all = jnp.concatenate([jnp.zeros_like(lb_sm[:1]), jnp.cumsum(lb_sm[1:], axis=0)], axis=0)
    h = x
    for i in range(DEPTH):
        h = h + 0.5 * swiglu(rms_norm(h, ffn_a_norm[i]), ffn_a_w_in[i], ffn_a_w_out[i])
        u = rms_norm(h, mix_norm[i])
        (c_q, c_kv, k_rope, sb_q, sb_k, sb_v,
         hg_q, hg_f, hg_i, hg_g, gate_logits) = split_cols(u @ w_in[i], IN_SPLITS)
        y_a = mla_attention(c_q, c_kv, k_rope, mla_q_norm[i], mla_w_uq[i],
                            mla_kv_norm[i], mla_w_ukv[i], cos, sin)
        y_b = stick_breaking_attention(sb_q, sb_k, sb_v)
        y_c = hgrn2_recurrence(hg_q, hg_f, hg_i, hg_g, lb_all[i], hgrn_out_norm[i])
        gates = jax.nn.sigmoid(gate_logits.astype(jnp.float32)).astype(h.dtype).reshape(B, S, N_BRANCH, D)
        merged = (gates[:, :, 0] * (y_a @ w_br_mla[i])
                  + gates[:, :, 1] * (y_b @ w_br_sb[i])
                  + gates[:, :, 2] * (y_c @ w_br_hgrn[i]))
        h = h + merged @ w_out[i]
        h = h + 0.5 * swiglu(rms_norm(h, ffn_b_norm[i]), ffn_b_w_in[i], ffn_b_w_out[i])
        h = h + (p[i] @ w_ple_proj[i]) * jax.nn.sigmoid(rms_norm(h, ple_norm[i]) @ w_ple_gate[i])
    return rms_norm(h, final_norm)
```

```cpp
#include <hip/hip_runtime.h>
#include <hip/hip_cooperative_groups.h>
#include <cstdio>
#include <cstdint>
namespace cg = cooperative_groups;

#define LAS __attribute__((address_space(3)))
typedef unsigned short bf16_t;
typedef short bf16x8 __attribute__((ext_vector_type(8)));
typedef short s16x4 __attribute__((ext_vector_type(4)));
typedef float f32x4 __attribute__((ext_vector_type(4)));
typedef float f32x16 __attribute__((ext_vector_type(16)));
typedef unsigned u32x4 __attribute__((ext_vector_type(4)));
typedef unsigned u32x2 __attribute__((ext_vector_type(2)));
typedef float f32x2_t __attribute__((ext_vector_type(2)));
typedef __bf16 bf16x2_t __attribute__((ext_vector_type(2)));

constexpr int T = 32768, DM = 1024, FF = 2816, SEQ = 2048, NBATCH = 16, DEPTH = 2;
constexpr int PW = 3744;
constexpr int PC_CQ = 0, PC_CKV = 384, PC_SBQ = 640, PC_SBK = 1152, PC_HQ = 1664, PC_HF = 2176, PC_HI = 2688, PC_HG = 3200, PC_KR = 3712;
constexpr int NWAVES = 8, NTHREADS = 512;
constexpr int LDS_BYTES = 131072 + 1024;
constexpr float EPS = 1e-6f;
#ifndef DUPMASK
#define DUPMASK 0
#endif
#ifndef PHASE_MASK
#define PHASE_MASK 0xFFFFFFFFu
#endif

constexpr size_t MiB = (size_t)1 << 20;
constexpr size_t WS_RS = 0;
constexpr size_t WS_BAR = 2 * MiB;
constexpr size_t WS_LBT = 3 * MiB;
constexpr size_t WS_WPLE = 6 * MiB;
constexpr size_t WPLE_STRIDE = (size_t)(1024 * 1024 + 1024 * 256) * 2;
constexpr size_t WS_W = 11 * MiB;
constexpr size_t WS_HB = 65 * MiB;
constexpr size_t WS_P = 129 * MiB;
constexpr size_t WS_TMP2 = 305 * MiB;
constexpr size_t WS_Q = 363 * MiB;
constexpr size_t WS_KN = 411 * MiB;
constexpr size_t WS_VT = 443 * MiB;
constexpr size_t WS_SBVT = 475 * MiB;
constexpr size_t WS_HBALT = 427 * MiB;
constexpr size_t WS_ROPE = 507 * MiB;
constexpr size_t WS_END = 511 * MiB;
constexpr size_t WO_A_IN = 0;
constexpr size_t WO_A_OUT = WO_A_IN + (size_t)5632 * 1024;
constexpr size_t WO_IN = WO_A_OUT + (size_t)1024 * 2816;
constexpr size_t WO_SBV = WO_IN + (size_t)3840 * 1024;
constexpr size_t WO_GATE = WO_SBV + (size_t)512 * 1024;
constexpr size_t WO_UQ = WO_GATE + (size_t)3072 * 1024;
constexpr size_t WO_UK = WO_UQ + (size_t)768 * 384;
constexpr size_t WO_UV = WO_UK + (size_t)512 * 256;
constexpr size_t WO_BR = WO_UV + (size_t)512 * 256;
constexpr size_t WO_OUT = WO_BR + (size_t)3 * 1024 * 512;
constexpr size_t WO_B_IN = WO_OUT + (size_t)1024 * 1024;
constexpr size_t WO_B_OUT = WO_B_IN + (size_t)5632 * 1024;
constexpr size_t WO_END = WO_B_OUT + (size_t)1024 * 2816;
static_assert(WO_END * 2 <= 54 * MiB, "weights fit");

struct Params {
    const float* x; const float* p; const int* pos;
    const float* ffn_a_norm; const float* ffn_a_w_in; const float* ffn_a_w_out; const float* mix_norm; const float* w_in;
    const float* mla_q_norm; const float* mla_w_uq; const float* mla_kv_norm; const float* mla_w_ukv; const float* lbraw; const float* hg_norm;
    const float* w_br_mla; const float* w_br_sb; const float* w_br_hgrn; const float* w_out; const float* ffn_b_norm; const float* ffn_b_w_in; const float* ffn_b_w_out;
    const float* ple_norm; const float* w_ple_gate; const float* w_ple_proj; const float* final_norm;
    float* out; unsigned char* ws; int ph_lo, ph_hi;
};

__device__ __forceinline__ int otid() { int t = threadIdx.x; asm volatile("" : "+v"(t)); return t; }
typedef const __attribute__((address_space(4))) Params* KPtr;
__device__ __forceinline__ KPtr kparams() { KPtr p = (KPtr)__builtin_amdgcn_kernarg_segment_ptr(); asm volatile("" : "+s"(p)); return p; }
__device__ __forceinline__ unsigned cvtpk(float lo, float hi) { f32x2_t v = {lo, hi}; bf16x2_t b = __builtin_convertvector(v, bf16x2_t); return __builtin_bit_cast(unsigned, b); }
__device__ __forceinline__ float bflo(unsigned w) { return __uint_as_float(w << 16); }
__device__ __forceinline__ float bfhi(unsigned w) { return __uint_as_float(w & 0xffff0000u); }
__device__ __forceinline__ float rstd_of(float ss, float invn) { return __builtin_amdgcn_rsqf(ss * invn + EPS); }
__device__ __forceinline__ float sigmoidf_(float x) { return __builtin_amdgcn_rcpf(1.f + __expf(-x)); }
__device__ __forceinline__ float siluf_(float x) { return x * __builtin_amdgcn_rcpf(1.f + __expf(-x)); }
__device__ __forceinline__ u32x4 pack8(f32x4 a, f32x4 b) { u32x4 w; w.x = cvtpk(a[0], a[1]); w.y = cvtpk(a[2], a[3]); w.z = cvtpk(b[0], b[1]); w.w = cvtpk(b[2], b[3]); return w; }
__device__ __forceinline__ void unpack8(u32x4 w, f32x4& a, f32x4& b) { a = (f32x4){bflo(w.x), bfhi(w.x), bflo(w.y), bfhi(w.y)}; b = (f32x4){bflo(w.z), bfhi(w.z), bflo(w.w), bfhi(w.w)}; }
#define LDS_BARRIER() do { asm volatile("s_waitcnt lgkmcnt(0)" ::: "memory"); __builtin_amdgcn_s_barrier(); asm volatile("" ::: "memory"); } while (0)
__device__ __forceinline__ int crow(int r, int hi) { return (r & 3) + 8 * (r >> 2) + 4 * hi; }
__device__ __forceinline__ void rope8(f32x4& x1, f32x4& x2, const float* cs, const float* sn, int fq) {
    const f32x4 c = *(const f32x4*)(cs + 4 * fq), s = *(const f32x4*)(sn + 4 * fq);
    const f32x4 a = x1, b = x2;
    x1 = a * c - b * s; x2 = b * c + a * s;
}
__device__ __forceinline__ void rope_table_entry(int pos, int i, float& cs, float& sn) {
    const float inv = __builtin_amdgcn_exp2f(-(float)i * 0.8304820237218406f);
    const float ang = (float)pos * inv;
    double rv = (double)ang * 0.15915494309189535; rv -= floor(rv);
    const float fr = (float)rv;
    sn = __builtin_amdgcn_sinf(fr); cs = __builtin_amdgcn_cosf(fr);
}

namespace pg8 {
constexpr int BM = 256, BK = 64, HALF = 128, HTB = HALF * BK * 2, NXCD = 8, WGM = 8;
__device__ __forceinline__ int lds_byte(int r, int c) { const int st = (r >> 4) * 2 + (c >> 5), rr = r & 15, cc = c & 31, ob = rr * 64 + cc * 2; return st * 1024 + (ob ^ (((ob >> 9) & 1) << 5)); }
__device__ __forceinline__ void stage_rc(int b, int& R, int& C) { const int st = b / 1024, sb = b % 1024, swz = sb ^ (((sb >> 9) & 1) << 5); R = (st >> 1) * 16 + swz / 64; C = (st & 1) * 32 + (swz % 64) / 2; }
__device__ __forceinline__ int perm32(int rho) { const int n = rho >> 4, i = rho & 15; return 8 * (i >> 2) + 4 * n + (i & 3); }
struct Unit { int pm, pn; };
struct Gemm { const bf16_t* A; const bf16_t* Bt; int lda, ldb, M, N, K; };
struct StaticOrder {
    int nM, nN, nwg, G, c;
    __device__ __forceinline__ void init(int M, int N, int G_, int c_) { nM = M / BM; nN = N / BM; nwg = nM * nN; G = G_; c = c_; }
    __device__ __forceinline__ bool next(int i, Unit& u) const {
        const long L = (long)i * G + c; if (L >= nwg) return false;
        int wgid = (int)L; { const int q = nwg / NXCD, r = nwg % NXCD, xcd = wgid % NXCD, off = wgid / NXCD; wgid = (xcd < r ? xcd * (q + 1) : r * (q + 1) + (xcd - r) * q) + off; }
        const int nig = WGM * nN, gid = wgid / nig, fm = gid * WGM, gsz = (nM - fm) < WGM ? (nM - fm) : WGM;
        u.pm = fm + ((wgid % nig) % gsz); u.pn = (wgid % nig) / gsz; return true;
    }
};
template <class Epi>
__device__ __forceinline__ void gemm_phase(LAS unsigned char* lds, const Gemm g, const StaticOrder& S, const Epi& E) {
    int tid_ = threadIdx.x; asm volatile("" : "+v"(tid_));
    const int tid = tid_, wid = __builtin_amdgcn_readfirstlane(tid >> 6), lane = tid & 63, wr = wid >> 2, wc = wid & 3, fr = lane & 15, fq = lane >> 4;
    const int K = g.K, nt = K / BK;
    unsigned voffA[2], voffB[2];
#pragma unroll
    for (int i = 0; i < 2; ++i) { int R, C; stage_rc(tid * 16 + i * 8192, R, C); const int Rb = (R & ~31) + perm32(R & 31);
        voffA[i] = (unsigned)(R * g.lda + C) * 2u; voffB[i] = (unsigned)((64 * (Rb >> 5) + (Rb & 31)) * g.ldb + C) * 2u; }
    const size_t kstep = (size_t)(BK * 2);
    const size_t hstepA = (size_t)HALF * g.lda * 2, tstepA = 2 * hstepA;
    const size_t hstepB = (size_t)32 * g.ldb * 2, tstepB = (size_t)BM * g.ldb * 2;
    const unsigned ldsw = (unsigned)wid * 1024u;
    const int aoff = lds_byte(wr * 64 + fr, fq * 8), boff = lds_byte(wc * 32 + fr, fq * 8);
#define PG8_SA(b, h) (((b) * 2 + (h)) * HTB)
#define PG8_SB(b, h) ((4 + (b) * 2 + (h)) * HTB)
#define PG8_STAGE(bufoff, gbase, voff) do { _Pragma("unroll") for (int _i = 0; _i < 2; ++_i) \
        __builtin_amdgcn_global_load_lds((const unsigned*)((const char*)(gbase) + (voff)[_i]), (LAS unsigned*)(lds + (bufoff) + ldsw + _i * 8192), 16, 0, 0); } while (0)
#define PG8_LDA(dst, b, h) do { _Pragma("unroll") for (int m = 0; m < 4; ++m) _Pragma("unroll") for (int k = 0; k < 2; ++k) dst[m][k] = *(const LAS bf16x8*)(lds + PG8_SA(b, h) + aoff + m * 2048 + k * 1024); } while (0)
#define PG8_LDB(dst, b, h) do { _Pragma("unroll") for (int n = 0; n < 2; ++n) _Pragma("unroll") for (int k = 0; k < 2; ++k) dst[n][k] = *(const LAS bf16x8*)(lds + PG8_SB(b, h) + boff + n * 2048 + k * 1024); } while (0)
#define PG8_MMA(ai, bj, At, Bt) do { __builtin_amdgcn_s_setprio(1); _Pragma("unroll") for (int m = 0; m < 4; ++m) _Pragma("unroll") for (int n = 0; n < 2; ++n) _Pragma("unroll") for (int k = 0; k < 2; ++k) \
        acc[ai][bj][m][n] = __builtin_amdgcn_mfma_f32_16x16x32_bf16(Bt[n][k], At[m][k], acc[ai][bj][m][n], 0, 0, 0); __builtin_amdgcn_s_setprio(0); } while (0)
#define PG8_WAIT_V(n) asm volatile("s_waitcnt vmcnt(" #n ")" ::: "memory")
#define PG8_WAIT_L(n) asm volatile("s_waitcnt lgkmcnt(" #n ")" ::: "memory")
#define PG8_BAR __builtin_amdgcn_s_barrier()
#define PG8_SCHED __builtin_amdgcn_sched_barrier(0)
    Unit cur, nxt; int ui = 0;
    if (!S.next(0, cur)) return;
    f32x4 acc[2][2][4][2];
#pragma unroll
    for (int a = 0; a < 2; ++a)
#pragma unroll
        for (int b = 0; b < 2; ++b)
#pragma unroll
            for (int m = 0; m < 4; ++m)
#pragma unroll
                for (int n = 0; n < 2; ++n) acc[a][b][m][n] = (f32x4){0.f, 0.f, 0.f, 0.f};
    bf16x8 At[4][2], B0[2][2], B1[2][2];
    const char* cA = (const char*)g.A + (size_t)cur.pm * tstepA; const char* cB = (const char*)g.Bt + (size_t)cur.pn * tstepB;
    PG8_STAGE(PG8_SB(0, 0), cB, voffB); PG8_STAGE(PG8_SB(0, 1), cB + hstepB, voffB); PG8_STAGE(PG8_SA(0, 0), cA, voffA); PG8_STAGE(PG8_SA(0, 1), cA + hstepA, voffA);
    if (wr == 1) PG8_BAR;
    PG8_WAIT_V(2); PG8_BAR;
    PG8_STAGE(PG8_SB(1, 0), cB + kstep, voffB); PG8_STAGE(PG8_SA(1, 0), cA + kstep, voffA); PG8_STAGE(PG8_SB(1, 1), cB + hstepB + kstep, voffB);
    PG8_WAIT_V(6); PG8_BAR;
    for (;;) {
        const bool has_next = S.next(ui + 1, nxt);
        const char* nA = has_next ? (const char*)g.A + (size_t)nxt.pm * tstepA : cA; const char* nB = has_next ? (const char*)g.Bt + (size_t)nxt.pn * tstepB : cB;
#pragma unroll 1
        for (int t = 0; t < nt; t += 2) {
            const bool last = (t == nt - 2);
            const char* a1 = cA + (size_t)(t + 1) * kstep;
            const char* a2 = last ? nA : cA + (size_t)(t + 2) * kstep; const char* b2 = last ? nB : cB + (size_t)(t + 2) * kstep;
            const char* a3 = a2 + kstep; const char* b3 = b2 + kstep;
            PG8_LDB(B0, 0, 0); PG8_LDB(B1, 0, 1); PG8_SCHED; PG8_LDA(At, 0, 0); PG8_STAGE(PG8_SA(1, 1), a1 + hstepA, voffA);
            PG8_WAIT_V(8); PG8_WAIT_L(0); PG8_BAR; PG8_MMA(0, 0, At, B0); PG8_MMA(0, 1, At, B1); PG8_BAR; PG8_SCHED;
            PG8_LDA(At, 0, 1); PG8_STAGE(PG8_SB(0, 0), b2, voffB); PG8_STAGE(PG8_SB(0, 1), b2 + hstepB, voffB); PG8_STAGE(PG8_SA(0, 0), a2, voffA);
            PG8_WAIT_V(8); PG8_WAIT_L(0); PG8_BAR; PG8_MMA(1, 0, At, B0); PG8_MMA(1, 1, At, B1); PG8_BAR; PG8_SCHED;
            PG8_LDB(B0, 1, 0); PG8_LDB(B1, 1, 1); PG8_SCHED; PG8_LDA(At, 1, 0); PG8_STAGE(PG8_SA(0, 1), a2 + hstepA, voffA);
            PG8_WAIT_V(8); PG8_WAIT_L(0); PG8_BAR; PG8_MMA(0, 0, At, B0); PG8_MMA(0, 1, At, B1); PG8_BAR; PG8_SCHED;
            PG8_LDA(At, 1, 1); PG8_STAGE(PG8_SB(1, 0), b3, voffB); PG8_STAGE(PG8_SB(1, 1), b3 + hstepB, voffB); PG8_STAGE(PG8_SA(1, 0), a3, voffA);
            PG8_WAIT_V(8); PG8_WAIT_L(0); PG8_BAR; PG8_MMA(1, 0, At, B0); PG8_MMA(1, 1, At, B1); PG8_BAR; PG8_SCHED;
        }
        if (wr == 0) PG8_BAR;
        E(acc, cur, wr, wc, fr, fq);
        if (!has_next) break;
#pragma unroll
        for (int a = 0; a < 2; ++a)
#pragma unroll
            for (int b = 0; b < 2; ++b)
#pragma unroll
                for (int m = 0; m < 4; ++m)
#pragma unroll
                    for (int n = 0; n < 2; ++n) acc[a][b][m][n] = (f32x4){0.f, 0.f, 0.f, 0.f};
        cur = nxt; cA = nA; cB = nB; ++ui;
        if (wr == 1) PG8_BAR;
    }
    PG8_WAIT_V(0);
    PG8_BAR;
#undef PG8_SA
#undef PG8_SB
#undef PG8_STAGE
#undef PG8_LDA
#undef PG8_LDB
#undef PG8_MMA
#undef PG8_WAIT_V
#undef PG8_WAIT_L
#undef PG8_BAR
#undef PG8_SCHED
}
typedef f32x4 Acc[2][2][4][2];

struct EpiSwiglu {
    bf16_t* H; const float* rs;
    __device__ __forceinline__ void operator()(const Acc& acc, const Unit& u, int wr, int wc, int fr, int fq) const {
        const int col0 = u.pn * 128 + wc * 32 + 8 * fq;
        float tpre[2][4];
#pragma unroll
        for (int ai = 0; ai < 2; ++ai)
#pragma unroll
            for (int m = 0; m < 4; ++m) tpre[ai][m] = rs[u.pm * BM + ai * HALF + wr * 64 + m * 16 + fr];
        asm volatile("" ::: "memory");
#pragma unroll
        for (int ai = 0; ai < 2; ++ai)
#pragma unroll
            for (int m = 0; m < 4; ++m) {
                const int r = u.pm * BM + ai * HALF + wr * 64 + m * 16 + fr; const float t = rstd_of(tpre[ai][m], 1.f / 1024.f);
                const float tl = -t * 1.4426950408889634f, t2 = t * t;
                f32x4 o0, o1;
#pragma unroll
                for (int n = 0; n < 2; ++n)
#pragma unroll
                    for (int jj = 0; jj < 2; ++jj) {
                        const f32x2_t g = {acc[ai][0][m][n][2 * jj], acc[ai][0][m][n][2 * jj + 1]}, uu = {acc[ai][1][m][n][2 * jj], acc[ai][1][m][n][2 * jj + 1]};
                        const f32x2_t z = g * tl; f32x2_t e; e.x = __builtin_amdgcn_exp2f(z.x); e.y = __builtin_amdgcn_exp2f(z.y);
                        const f32x2_t d = e + 1.0f; f32x2_t rr; rr.x = __builtin_amdgcn_rcpf(d.x); rr.y = __builtin_amdgcn_rcpf(d.y);
                        const f32x2_t o = (g * uu) * (rr * t2);
                        if (n == 0) { o0[2 * jj] = o.x; o0[2 * jj + 1] = o.y; } else { o1[2 * jj] = o.x; o1[2 * jj + 1] = o.y; }
                    }
                *(u32x4*)(H + (size_t)r * FF + col0) = pack8(o0, o1);
            }
    }
};
template <bool PLE> struct EpiResid {
    const float* hsrc; float* h; bf16_t* hb; float* rs_out; float alpha; const bf16_t* tmp; const float* rs_in; int dry;
    __device__ __forceinline__ void operator()(const Acc& acc, const Unit& u, int wr, int wc, int fr, int fq) const {
        constexpr int MB = PLE ? 2 : 4;
#pragma unroll
        for (int ai = 0; ai < 2; ++ai)
#pragma unroll
        for (int mb = 0; mb < 4; mb += MB) {
            f32x4 pa[MB][2], pb[MB][2]; u32x4 pt[MB][2]; float tt[MB];
#pragma unroll
            for (int mm = 0; mm < MB; ++mm) {
                const int m = mb + mm; const int r = u.pm * BM + ai * HALF + wr * 64 + m * 16 + fr;
                tt[mm] = PLE ? rs_in[r] : 0.f;
#pragma unroll
                for (int bj = 0; bj < 2; ++bj) {
                    const int c0 = u.pn * BM + wc * 64 + bj * 32 + 8 * fq; const float* hs = hsrc + (size_t)r * DM + c0;
                    pa[mm][bj] = *(const f32x4*)hs; pb[mm][bj] = *(const f32x4*)(hs + 4);
                    if (PLE) pt[mm][bj] = *(const u32x4*)(tmp + (size_t)r * DM + c0);
                }
            }
#pragma unroll
            for (int mm = 0; mm < MB; ++mm) {
                const int m = mb + mm; const int r = u.pm * BM + ai * HALF + wr * 64 + m * 16 + fr; float ss = 0.f;
                const float t = PLE ? rstd_of(tt[mm], 1.f / 1024.f) : 1.f; const float tl = -t * 1.4426950408889634f; (void)tl;
#pragma unroll
                for (int bj = 0; bj < 2; ++bj) {
                    const int c0 = u.pn * BM + wc * 64 + bj * 32 + 8 * fq; float* hp = h + (size_t)r * DM + c0;
                    f32x4 a = pa[mm][bj], b = pb[mm][bj];
                    if (PLE) { f32x4 ta, tb; unpack8(pt[mm][bj], ta, tb);
#pragma unroll
                        for (int j = 0; j < 4; ++j) { a[j] += ta[j] * __builtin_amdgcn_rcpf(1.f + __builtin_amdgcn_exp2f(acc[ai][bj][m][0][j] * tl)); b[j] += tb[j] * __builtin_amdgcn_rcpf(1.f + __builtin_amdgcn_exp2f(acc[ai][bj][m][1][j] * tl)); } }
                    else { a += acc[ai][bj][m][0] * alpha; b += acc[ai][bj][m][1] * alpha; }
                    if (!dry || a[0] == 1234.56789f) { *(f32x4*)hp = a; *(f32x4*)(hp + 4) = b;
                    *(u32x4*)(hb + (size_t)r * DM + c0) = pack8(a, b); }
                    ss += (a[0] * a[0] + a[1] * a[1]) + (a[2] * a[2] + a[3] * a[3]) + (b[0] * b[0] + b[1] * b[1]) + (b[2] * b[2] + b[3] * b[3]);
                }
                ss += __shfl_xor(ss, 16); ss += __shfl_xor(ss, 32);
                if (fq == 0 && (!dry || ss == 1234.56789f)) unsafeAtomicAdd(rs_out + r, ss);
            }
            asm volatile("" ::: "memory");
        }
    }
};
struct EpiInproj {
    bf16_t* P; const float* rs; float* rs_q; float* rs_kv; const float* rope; const float* lbt; int dry;
    __device__ __forceinline__ void operator()(const Acc& acc, const Unit& u, int wr, int wc, int fr, int fq) const {
        float tpre[2][4];
#pragma unroll
        for (int ai = 0; ai < 2; ++ai)
#pragma unroll
            for (int m = 0; m < 4; ++m) tpre[ai][m] = rs[u.pm * BM + ai * HALF + wr * 64 + m * 16 + fr];
        asm volatile("" ::: "memory");
#pragma unroll
        for (int ai = 0; ai < 2; ++ai)
#pragma unroll
            for (int m = 0; m < 4; ++m) {
                const int r = u.pm * BM + ai * HALF + wr * 64 + m * 16 + fr; const float t = rstd_of(tpre[ai][m], 1.f / 1024.f);
#pragma unroll
                for (int bj = 0; bj < 2; ++bj) {
                    const int G32 = 8 * u.pn + 2 * wc + bj; const int c0 = 32 * G32 + 8 * fq;
                    f32x4 v0 = acc[ai][bj][m][0] * t, v1 = acc[ai][bj][m][1] * t;
                    if (G32 < 20) {
                        float ss = (v0[0] * v0[0] + v0[1] * v0[1]) + (v0[2] * v0[2] + v0[3] * v0[3]) + (v1[0] * v1[0] + v1[1] * v1[1]) + (v1[2] * v1[2] + v1[3] * v1[3]);
                        ss += __shfl_xor(ss, 16); ss += __shfl_xor(ss, 32);
                        if (fq == 0 && (!dry || ss == 1234.56789f)) unsafeAtomicAdd((G32 < 12 ? rs_q : rs_kv) + r, ss);
                    }
                    if (G32 >= 52 && G32 < 68) {
#pragma unroll
                        for (int j = 0; j < 4; ++j) { v0[j] = siluf_(v0[j]); v1[j] = siluf_(v1[j]); }
                    } else if (G32 >= 68 && G32 < 84) {
                        const f32x4 l0 = *(const f32x4*)(lbt + 32 * (G32 - 68) + 8 * fq), l1 = *(const f32x4*)(lbt + 32 * (G32 - 68) + 8 * fq + 4);
#pragma unroll
                        for (int j = 0; j < 4; ++j) {
                            { const float x = v0[j], e = __expf(-fabsf(x)), d = __builtin_amdgcn_rcpf(1.f + e), sp = x >= 0.f ? d : e * d; v0[j] = __builtin_amdgcn_logf(fminf(fmaxf(l0[j], 1e-30f) + (1.f - l0[j]) * sp, 1.f)); }
                            { const float x = v1[j], e = __expf(-fabsf(x)), d = __builtin_amdgcn_rcpf(1.f + e), sp = x >= 0.f ? d : e * d; v1[j] = __builtin_amdgcn_logf(fminf(fmaxf(l1[j], 1e-30f) + (1.f - l1[j]) * sp, 1.f)); }
                        }
                    }
                    if (G32 > 116) continue;
                    if (G32 == 116) { rope8(v0, v1, rope + (size_t)r * 16, rope + (size_t)T * 16 + (size_t)r * 16, fq); }
                    if (!dry || v0[0] == 1234.56789f) *(u32x4*)(P + (size_t)r * PW + c0) = pack8(v0, v1);
                }
            }
    }
};
struct EpiQup {
    bf16_t* Q; const float* rs_q; const float* rope;
    __device__ __forceinline__ void operator()(const Acc& acc, const Unit& u, int wr, int wc, int fr, int fq) const {
        float tpre[2][4];
#pragma unroll
        for (int ai = 0; ai < 2; ++ai)
#pragma unroll
            for (int m = 0; m < 4; ++m) tpre[ai][m] = rs_q[u.pm * BM + ai * HALF + wr * 64 + m * 16 + fr];
        asm volatile("" ::: "memory");
#pragma unroll
        for (int ai = 0; ai < 2; ++ai)
#pragma unroll
            for (int m = 0; m < 4; ++m) {
                const int r = u.pm * BM + ai * HALF + wr * 64 + m * 16 + fr; const float t = rstd_of(tpre[ai][m], 1.f / 384.f);
#pragma unroll
                for (int bj = 0; bj < 2; ++bj) {
                    const int c0 = u.pn * BM + wc * 64 + bj * 32 + 8 * fq;
                    f32x4 v0 = acc[ai][bj][m][0] * t, v1 = acc[ai][bj][m][1] * t;
                    if (u.pn == 2) rope8(v0, v1, rope + (size_t)r * 16, rope + (size_t)T * 16 + (size_t)r * 16, fq);
                    *(u32x4*)(Q + (size_t)r * 768 + c0) = pack8(v0, v1);
                }
            }
    }
};
struct EpiStore {
    bf16_t* O; int ldc; const float* rs; float invn; int sig;
    __device__ __forceinline__ void operator()(const Acc& acc, const Unit& u, int wr, int wc, int fr, int fq) const {
        float tpre[2][4];
#pragma unroll
        for (int ai = 0; ai < 2; ++ai)
#pragma unroll
            for (int m = 0; m < 4; ++m) tpre[ai][m] = rs ? rs[u.pm * BM + ai * HALF + wr * 64 + m * 16 + fr] : 0.f;
        asm volatile("" ::: "memory");
#pragma unroll
        for (int ai = 0; ai < 2; ++ai)
#pragma unroll
            for (int m = 0; m < 4; ++m) {
                const int r = u.pm * BM + ai * HALF + wr * 64 + m * 16 + fr; const float t = rs ? rstd_of(tpre[ai][m], invn) : 1.f;
#pragma unroll
                for (int bj = 0; bj < 2; ++bj) {
                    const int c0 = u.pn * BM + wc * 64 + bj * 32 + 8 * fq;
                    f32x4 v0 = acc[ai][bj][m][0] * t, v1 = acc[ai][bj][m][1] * t;
                    if (sig) { const float tl = -t * 1.4426950408889634f; const f32x4 z0 = acc[ai][bj][m][0] * tl, z1 = acc[ai][bj][m][1] * tl;
#pragma unroll
                        for (int j = 0; j < 4; ++j) { v0[j] = __builtin_amdgcn_rcpf(1.f + __builtin_amdgcn_exp2f(z0[j])); v1[j] = __builtin_amdgcn_rcpf(1.f + __builtin_amdgcn_exp2f(z1[j])); } }
                    *(u32x4*)(O + (size_t)r * ldc + c0) = pack8(v0, v1);
                }
            }
    }
};
struct EpiStoreCol {
    bf16_t* O; int ldc; const float* rs; float invn;
    __device__ __forceinline__ void operator()(const Acc& acc, const Unit& u, int wr, int wc, int fr, int fq) const {
#pragma unroll
        for (int bj = 0; bj < 2; ++bj) {
            const int c0 = u.pn * BM + wc * 64 + bj * 32 + 8 * fq;
            f32x4 t0 = *(const f32x4*)(rs + c0), t1 = *(const f32x4*)(rs + c0 + 4);
#pragma unroll
            for (int j = 0; j < 4; ++j) { t0[j] = rstd_of(t0[j], invn); t1[j] = rstd_of(t1[j], invn); }
#pragma unroll
            for (int ai = 0; ai < 2; ++ai)
#pragma unroll
                for (int m = 0; m < 4; ++m) {
                    const int r = u.pm * BM + ai * HALF + wr * 64 + m * 16 + fr;
                    *(u32x4*)(O + (size_t)r * ldc + c0) = pack8(acc[ai][bj][m][0] * t0, acc[ai][bj][m][1] * t1);
                }
        }
    }
};
struct EpiBranch {
    bf16_t* Mg; const bf16_t* G; int ldg; int first;
    __device__ __forceinline__ void operator()(const Acc& acc, const Unit& u, int wr, int wc, int fr, int fq) const {
#pragma unroll
        for (int ai = 0; ai < 2; ++ai) {
            u32x4 pg[4][2], pm_[4][2];
#pragma unroll
            for (int m = 0; m < 4; ++m) {
                const int r = u.pm * BM + ai * HALF + wr * 64 + m * 16 + fr;
#pragma unroll
                for (int bj = 0; bj < 2; ++bj) {
                    const int c0 = u.pn * BM + wc * 64 + bj * 32 + 8 * fq;
                    pg[m][bj] = *(const u32x4*)(G + (size_t)r * ldg + c0);
                    pm_[m][bj] = first ? (u32x4){0u, 0u, 0u, 0u} : *(const u32x4*)(Mg + (size_t)r * DM + c0);
                }
            }
#pragma unroll
            for (int m = 0; m < 4; ++m) {
                const int r = u.pm * BM + ai * HALF + wr * 64 + m * 16 + fr;
#pragma unroll
                for (int bj = 0; bj < 2; ++bj) {
                    const int c0 = u.pn * BM + wc * 64 + bj * 32 + 8 * fq;
                    f32x4 g0, g1, m0, m1; unpack8(pg[m][bj], g0, g1); unpack8(pm_[m][bj], m0, m1);
                    m0 += g0 * acc[ai][bj][m][0]; m1 += g1 * acc[ai][bj][m][1];
                    *(u32x4*)(Mg + (size_t)r * DM + c0) = pack8(m0, m1);
                }
            }
            asm volatile("" ::: "memory");
        }
    }
};
}

template <class Epi>
__device__ __forceinline__ void run_gemm(LAS unsigned char* lds, const bf16_t* A, int lda, const bf16_t* Bt, int ldb, int M, int N, int K, const Epi& E) {
    pg8::Gemm g{A, Bt, lda, ldb, M, N, K}; pg8::StaticOrder S; S.init(M, N, (int)gridDim.x, (int)blockIdx.x);
    pg8::gemm_phase<Epi>(lds, g, S, E);
}

enum { MAP_ID = 0, MAP_SWIGLU, MAP_INMAIN, MAP_UQ, MAP_UK, MAP_UV };
__device__ __forceinline__ int src_col(int map, int off, int n) {
    switch (map) {
        case MAP_ID: return off + n;
        case MAP_SWIGLU: { const int pn = n >> 8, c = n & 255, wc = c >> 6, bj = (c >> 5) & 1, i = c & 31; return bj * FF + 128 * pn + 32 * wc + i; }
        case MAP_INMAIN: {
            if (n < 640) return n;
            if (n < 1664) return 672 + (n - 640);
            if (n < 3712) return 2208 + (n - 1664);
            if (n < 3744) { const int pp = n - 3712, a = pp >> 3, nn = (pp >> 2) & 1, j = pp & 3; return 640 + 16 * nn + 4 * a + j; }
            return -1; }
        case MAP_UQ: {
            if (n < 512) { const int hh = n >> 6, d = n & 63; return 96 * hh + d; }
            const int p = n - 512, hh = p >> 5, pp = p & 31, a = pp >> 3, nn = (pp >> 2) & 1, j = pp & 3; return 96 * hh + 64 + 16 * nn + 4 * a + j; }
        case MAP_UK: { const int hh = n >> 6, d = n & 63; return 128 * hh + d; }
        default: { const int hh = n >> 6, d = n & 63; return 128 * hh + 64 + d; }
    }
}
struct Job { const float* W; const float* gain; bf16_t* dst; int K, Nsrc, Nd, map, off; };
__device__ __forceinline__ Job get_job(int layer, int j) {
    KPtr P = kparams();
    Job J; bf16_t* wb = (bf16_t*)(P->ws + WS_W); bf16_t* wp = (bf16_t*)(P->ws + WS_WPLE + (size_t)layer * WPLE_STRIDE);
    J.gain = nullptr; J.map = MAP_ID; J.off = 0;
    switch (j) {
        case 0: J.W = P->ffn_a_w_in + (size_t)layer * 1024 * 5632; J.gain = P->ffn_a_norm + layer * 1024; J.dst = wb + WO_A_IN; J.K = 1024; J.Nsrc = 5632; J.Nd = 5632; J.map = MAP_SWIGLU; break;
        case 1: J.W = P->ffn_a_w_out + (size_t)layer * 2816 * 1024; J.dst = wb + WO_A_OUT; J.K = 2816; J.Nsrc = 1024; J.Nd = 1024; break;
        case 2: J.W = P->w_in + (size_t)layer * 1024 * 7328; J.gain = P->mix_norm + layer * 1024; J.dst = wb + WO_IN; J.K = 1024; J.Nsrc = 7328; J.Nd = 3840; J.map = MAP_INMAIN; break;
        case 3: J.W = P->w_in + (size_t)layer * 1024 * 7328; J.gain = P->mix_norm + layer * 1024; J.dst = wb + WO_SBV; J.K = 1024; J.Nsrc = 7328; J.Nd = 512; J.off = 1696; break;
        case 4: J.W = P->w_in + (size_t)layer * 1024 * 7328; J.gain = P->mix_norm + layer * 1024; J.dst = wb + WO_GATE; J.K = 1024; J.Nsrc = 7328; J.Nd = 3072; J.off = 4256; break;
        case 5: J.W = P->mla_w_uq + (size_t)layer * 384 * 768; J.gain = P->mla_q_norm + layer * 384; J.dst = wb + WO_UQ; J.K = 384; J.Nsrc = 768; J.Nd = 768; J.map = MAP_UQ; break;
        case 6: J.W = P->mla_w_ukv + (size_t)layer * 256 * 1024; J.gain = P->mla_kv_norm + layer * 256; J.dst = wb + WO_UK; J.K = 256; J.Nsrc = 1024; J.Nd = 512; J.map = MAP_UK; break;
        case 7: J.W = P->mla_w_ukv + (size_t)layer * 256 * 1024; J.gain = P->mla_kv_norm + layer * 256; J.dst = wb + WO_UV; J.K = 256; J.Nsrc = 1024; J.Nd = 512; J.map = MAP_UV; break;
        case 8: J.W = P->w_br_mla + (size_t)layer * 512 * 1024; J.dst = wb + WO_BR; J.K = 512; J.Nsrc = 1024; J.Nd = 1024; break;
        case 9: J.W = P->w_br_sb + (size_t)layer * 512 * 1024; J.dst = wb + WO_BR + (size_t)1024 * 512; J.K = 512; J.Nsrc = 1024; J.Nd = 1024; break;
        case 10: J.W = P->w_br_hgrn + (size_t)layer * 512 * 1024; J.dst = wb + WO_BR + (size_t)2 * 1024 * 512; J.K = 512; J.Nsrc = 1024; J.Nd = 1024; break;
        case 11: J.W = P->w_out + (size_t)layer * 1024 * 1024; J.dst = wb + WO_OUT; J.K = 1024; J.Nsrc = 1024; J.Nd = 1024; break;
        case 12: J.W = P->ffn_b_w_in + (size_t)layer * 1024 * 5632; J.gain = P->ffn_b_norm + layer * 1024; J.dst = wb + WO_B_IN; J.K = 1024; J.Nsrc = 5632; J.Nd = 5632; J.map = MAP_SWIGLU; break;
        case 13: J.W = P->ffn_b_w_out + (size_t)layer * 2816 * 1024; J.dst = wb + WO_B_OUT; J.K = 2816; J.Nsrc = 1024; J.Nd = 1024; break;
        case 14: J.W = P->w_ple_gate + (size_t)layer * 1024 * 1024; J.gain = P->ple_norm + layer * 1024; J.dst = wp; J.K = 1024; J.Nsrc = 1024; J.Nd = 1024; break;
        default: J.W = P->w_ple_proj + (size_t)layer * 256 * 1024; J.dst = wp + (size_t)1024 * 1024; J.K = 256; J.Nsrc = 1024; J.Nd = 1024; break;
    }
    return J;
}
__device__ __forceinline__ void convert_item(const Job& J, LAS float* scr, int item, int lane) {
    const int nblk = J.Nd / 32, kb = item / nblk, nb = item % nblk, k0 = 64 * kb, n0 = 32 * nb;
    const int sc = src_col(J.map, J.off, n0 + (lane & 31));
    const float* src = J.W + (size_t)(k0 + (lane >> 5)) * J.Nsrc + (sc >= 0 ? sc : 0);
    float vals[32];
#pragma unroll
    for (int i = 0; i < 32; ++i) vals[i] = src[(size_t)(2 * i) * J.Nsrc];
    const int c = lane & 7;
    f32x4 g0 = {1.f, 1.f, 1.f, 1.f}, g1 = g0;
    if (J.gain) { g0 = *(const f32x4*)(J.gain + k0 + 8 * c); g1 = *(const f32x4*)(J.gain + k0 + 8 * c + 4); }
#pragma unroll
    for (int i = 0; i < 32; ++i) scr[(2 * i + (lane >> 5)) * 33 + (lane & 31)] = sc >= 0 ? vals[i] : 0.f;
    asm volatile("s_waitcnt lgkmcnt(0)" ::: "memory");
#pragma unroll
    for (int j = 0; j < 4; ++j) { const int n = (lane >> 3) + 8 * j; const LAS float* s = scr + (8 * c) * 33 + n;
        u32x4 o; o.x = cvtpk(s[0 * 33] * g0[0], s[1 * 33] * g0[1]); o.y = cvtpk(s[2 * 33] * g0[2], s[3 * 33] * g0[3]); o.z = cvtpk(s[4 * 33] * g1[0], s[5 * 33] * g1[1]); o.w = cvtpk(s[6 * 33] * g1[2], s[7 * 33] * g1[3]);
        *(u32x4*)(J.dst + (size_t)(n0 + n) * J.K + k0 + 8 * c) = o; }
    asm volatile("s_waitcnt lgkmcnt(0)" ::: "memory");
}
__device__ __forceinline__ void convert_weights(LAS unsigned char* lds, int layer, int j0, int j1) {
    const int tid = otid(); const int lane = tid & 63, wid = tid >> 6;
    LAS float* scr = (LAS float*)(lds + wid * 8704);
    const int gw = blockIdx.x * NWAVES + wid, NGW = gridDim.x * NWAVES;
    for (int j = j0; j < j1; ++j) {
        const Job J = get_job(layer, j);
        const int nitems = (J.K / 64) * (J.Nd / 32);
        for (int it = gw; it < nitems; it += NGW) convert_item(J, scr, it, lane);
    }
}

constexpr int MLA_KSTR = 208, MLA_VSTR = 144, MLA_KB = 64 * MLA_KSTR, MLA_VB = 64 * MLA_VSTR;
template <bool DRY> __device__ __forceinline__ void mla_unit(LAS unsigned char* lds, int b, int h, int qb, const bf16_t* Q, const bf16_t* Kn, const bf16_t* Pm, const bf16_t* VT, bf16_t* Y) {
    const int tid = otid(), lane = tid & 63, r32 = lane & 31, hi = lane >> 5; const int wid = __builtin_amdgcn_readfirstlane(tid >> 6);
    const int NT = 4 * qb + 4, tmax = 4 * qb + (wid >> 1);
    const size_t tok0 = (size_t)b * SEQ;
    const size_t qtok = tok0 + qb * 256 + wid * 32 + r32;
    const bf16_t* qrow = Q + qtok * 768;
    bf16x8 qf[6];
#pragma unroll
    for (int s = 0; s < 4; ++s) qf[s] = *(const bf16x8*)(qrow + h * 64 + 16 * s + 8 * hi);
#pragma unroll
    for (int s = 0; s < 2; ++s) qf[4 + s] = *(const bf16x8*)(qrow + 512 + h * 32 + 16 * s + 8 * hi);
    const int ka_row = tid >> 3, ka_c = tid & 7, kb_row = (tid & 255) >> 2, kb_c = tid & 3;
    const bf16_t* ka_src = Kn + (tok0 + ka_row) * 512 + h * 64 + ka_c * 8;
    const bf16_t* kb_src = Pm + (tok0 + kb_row) * PW + PC_KR + kb_c * 8;
    const bf16_t* va_src = VT + (size_t)(h * 64 + ka_row) * T + tok0 + ka_c * 8;
    const int ka_dst = ka_row * MLA_KSTR + ka_c * 16, kb_dst = kb_row * MLA_KSTR + 128 + kb_c * 16, va_dst = ka_row * MLA_VSTR + ka_c * 16;
    u32x4 ra = *(const u32x4*)ka_src, rb = *(const u32x4*)kb_src, rv = *(const u32x4*)va_src;
    float m_run = -1e30f, l_run = 0.f; f32x16 o0 = {}, o1 = {};
    const float C = 0.10206207261596577f * 1.4426950408889634f;
    for (int t = 0; t < NT; ++t) {
        LAS unsigned char* kbuf = lds + (t & 1) * MLA_KB; LAS unsigned char* vbuf = lds + 2 * MLA_KB + (t & 1) * MLA_VB;
        *(LAS u32x4*)(kbuf + ka_dst) = ra; if (tid < 256) *(LAS u32x4*)(kbuf + kb_dst) = rb; *(LAS u32x4*)(vbuf + va_dst) = rv;
        LDS_BARRIER();
        if (t + 1 < NT) { ra = *(const u32x4*)(ka_src + (size_t)(t + 1) * 64 * 512); rb = *(const u32x4*)(kb_src + (size_t)(t + 1) * 64 * PW); rv = *(const u32x4*)(va_src + (t + 1) * 64); }
        if (t <= tmax) {
            f32x16 p0 = {}, p1 = {};
#pragma unroll
            for (int s = 0; s < 6; ++s) {
                const bf16x8 a0 = *(const LAS bf16x8*)(kbuf + r32 * MLA_KSTR + s * 32 + hi * 16);
                const bf16x8 a1 = *(const LAS bf16x8*)(kbuf + (32 + r32) * MLA_KSTR + s * 32 + hi * 16);
                p0 = __builtin_amdgcn_mfma_f32_32x32x16_bf16(a0, qf[s], p0, 0, 0, 0);
                p1 = __builtin_amdgcn_mfma_f32_32x32x16_bf16(a1, qf[s], p1, 0, 0, 0);
            }
            float mx = fmaxf(p0[0], p1[0]);
#pragma unroll
            for (int r = 1; r < 16; ++r) mx = fmaxf(mx, fmaxf(p0[r], p1[r]));
            mx = fmaxf(mx, __shfl_xor(mx, 32));
            const float cand = mx * C; const bool grow = cand > m_run + 8.f;
            const float m_new = grow ? cand : m_run; const bool anyg = __any(grow);
            const float alpha = anyg ? __builtin_amdgcn_exp2f(m_run - m_new) : 1.f; m_run = m_new;
            float ls = 0.f;
#pragma unroll
            for (int r = 0; r < 16; ++r) { p0[r] = __builtin_amdgcn_exp2f(p0[r] * C - m_new); p1[r] = __builtin_amdgcn_exp2f(p1[r] * C - m_new); ls += p0[r] + p1[r]; }
            if (anyg) { l_run *= alpha;
#pragma unroll
                for (int r = 0; r < 16; ++r) { o0[r] *= alpha; o1[r] *= alpha; } }
            l_run += ls;
            u32x4 pw[4];
#pragma unroll
            for (int s = 0; s < 2; ++s) {
                pw[s] = (u32x4){cvtpk(p0[8 * s + 0], p0[8 * s + 1]), cvtpk(p0[8 * s + 2], p0[8 * s + 3]), cvtpk(p0[8 * s + 4], p0[8 * s + 5]), cvtpk(p0[8 * s + 6], p0[8 * s + 7])};
                pw[2 + s] = (u32x4){cvtpk(p1[8 * s + 0], p1[8 * s + 1]), cvtpk(p1[8 * s + 2], p1[8 * s + 3]), cvtpk(p1[8 * s + 4], p1[8 * s + 5]), cvtpk(p1[8 * s + 6], p1[8 * s + 7])};
            }
#pragma unroll
            for (int ks = 0; ks < 4; ++ks) {
                const bf16x8 pf = __builtin_bit_cast(bf16x8, pw[ks]);
                const s16x4 l0 = *(const LAS s16x4*)(vbuf + r32 * MLA_VSTR + (16 * ks + 4 * hi) * 2);
                const s16x4 h0 = *(const LAS s16x4*)(vbuf + r32 * MLA_VSTR + (16 * ks + 8 + 4 * hi) * 2);
                const s16x4 l1 = *(const LAS s16x4*)(vbuf + (32 + r32) * MLA_VSTR + (16 * ks + 4 * hi) * 2);
                const s16x4 h1 = *(const LAS s16x4*)(vbuf + (32 + r32) * MLA_VSTR + (16 * ks + 8 + 4 * hi) * 2);
                const bf16x8 v0 = (bf16x8){l0[0], l0[1], l0[2], l0[3], h0[0], h0[1], h0[2], h0[3]};
                const bf16x8 v1 = (bf16x8){l1[0], l1[1], l1[2], l1[3], h1[0], h1[1], h1[2], h1[3]};
                o0 = __builtin_amdgcn_mfma_f32_32x32x16_bf16(v0, pf, o0, 0, 0, 0);
                o1 = __builtin_amdgcn_mfma_f32_32x32x16_bf16(v1, pf, o1, 0, 0, 0);
            }
        }
    }
    const float l = l_run + __shfl_xor(l_run, 32); const float inv = 1.f / l;
    bf16_t* yrow = Y + qtok * 768 + h * 64;
#pragma unroll
    for (int g = 0; g < 4; ++g) {
        u32x2 w0, w1;
        w0.x = cvtpk(o0[4 * g] * inv, o0[4 * g + 1] * inv); w0.y = cvtpk(o0[4 * g + 2] * inv, o0[4 * g + 3] * inv);
        w1.x = cvtpk(o1[4 * g] * inv, o1[4 * g + 1] * inv); w1.y = cvtpk(o1[4 * g + 2] * inv, o1[4 * g + 3] * inv);
        if (!DRY || l == 1234.56789f) { *(u32x2*)(yrow + 8 * g + 4 * hi) = w0; *(u32x2*)(yrow + 32 + 8 * g + 4 * hi) = w1; }
    }
}

struct SbFrags { bf16x8 kf[4]; s16x4 v[8]; };
__device__ __forceinline__ void sb_load(SbFrags& F, const bf16_t* Pm, const bf16_t* VT, size_t tok0, int kv0, int h, int r32, int hi) {
    const bf16_t* krow = Pm + (tok0 + kv0 + r32) * PW + PC_SBK + h * 64;
#pragma unroll
    for (int s = 0; s < 4; ++s) F.kf[s] = *(const bf16x8*)(krow + 16 * s + 8 * hi);
#pragma unroll
    for (int s = 0; s < 2; ++s) {
        const bf16_t* v0p = VT + (size_t)(h * 64 + r32) * T + tok0 + kv0 + 16 * s + 4 * hi; const bf16_t* v1p = v0p + (size_t)32 * T;
        F.v[4 * s + 0] = *(const s16x4*)v0p; F.v[4 * s + 1] = *(const s16x4*)(v0p + 8); F.v[4 * s + 2] = *(const s16x4*)v1p; F.v[4 * s + 3] = *(const s16x4*)(v1p + 8);
    }
}
template <bool DRY> __device__ __forceinline__ void sb_unit(int b, int h, int qi, bf16_t* Pm, const bf16_t* VT) {
    const int lane = otid() & 63, r32 = lane & 31, hi = lane >> 5;
    const size_t tok0 = (size_t)b * SEQ; const int q0 = qi * 32;
    bf16_t* qrow = Pm + (tok0 + q0 + r32) * PW + PC_SBQ + h * 64;
    bf16x8 qf[4];
#pragma unroll
    for (int s = 0; s < 4; ++s) qf[s] = *(const bf16x8*)(qrow + 16 * s + 8 * hi);
    float R = 0.f; f32x16 o0 = {}, o1 = {};
    SbFrags cur, nxt;
    sb_load(cur, Pm, VT, tok0, qi * 32, h, r32, hi);
#pragma unroll 1
    for (int kt = qi; kt >= 0; --kt) {
        sb_load(nxt, Pm, VT, tok0, (kt > 0 ? kt - 1 : 0) * 32, h, r32, hi);
        f32x16 p = {};
#pragma unroll
        for (int s = 0; s < 4; ++s) p = __builtin_amdgcn_mfma_f32_32x32x16_bf16(cur.kf[s], qf[s], p, 0, 0, 0);
        const bool diag = (kt == qi);
        float lk[16], inner[16], Tg[4], TP[4], pre[4];
#pragma unroll
        for (int r = 0; r < 16; ++r) {
            const float z = p[r] * 0.125f; p[r] = z;
            const float e = __expf(-fabsf(z)); const float sp = fmaxf(z, 0.f) + __logf(1.f + e);
            const bool valid = !diag || (crow(r, hi) < r32);
            lk[r] = valid ? -sp : 0.f;
        }
#pragma unroll
        for (int g = 0; g < 4; ++g) {
            const float s3 = lk[4 * g + 3], s2 = s3 + lk[4 * g + 2], s1 = s2 + lk[4 * g + 1];
            inner[4 * g + 3] = 0.f; inner[4 * g + 2] = s3; inner[4 * g + 1] = s2; inner[4 * g] = s1; Tg[g] = s1 + lk[4 * g];
            TP[g] = __shfl_xor(Tg[g], 32);
        }
        float run = 0.f;
#pragma unroll
        for (int g = 3; g >= 0; --g) { pre[g] = run + (hi == 0 ? TP[g] : 0.f); run += Tg[g] + TP[g]; }
#pragma unroll
        for (int r = 0; r < 16; ++r) {
            const bool valid = !diag || (crow(r, hi) < r32);
            const float ex = fminf(p[r] + lk[r] + R + pre[r >> 2] + inner[r], 0.f);
            p[r] = valid ? __expf(ex) : 0.f;
        }
        R += run;
#pragma unroll
        for (int s = 0; s < 2; ++s) {
            const u32x4 pw = (u32x4){cvtpk(p[8 * s + 0], p[8 * s + 1]), cvtpk(p[8 * s + 2], p[8 * s + 3]), cvtpk(p[8 * s + 4], p[8 * s + 5]), cvtpk(p[8 * s + 6], p[8 * s + 7])};
            const bf16x8 pf = __builtin_bit_cast(bf16x8, pw);
            const s16x4 l0 = cur.v[4 * s], h0 = cur.v[4 * s + 1], l1 = cur.v[4 * s + 2], h1 = cur.v[4 * s + 3];
            const bf16x8 v0 = (bf16x8){l0[0], l0[1], l0[2], l0[3], h0[0], h0[1], h0[2], h0[3]};
            const bf16x8 v1 = (bf16x8){l1[0], l1[1], l1[2], l1[3], h1[0], h1[1], h1[2], h1[3]};
            o0 = __builtin_amdgcn_mfma_f32_32x32x16_bf16(v0, pf, o0, 0, 0, 0);
            o1 = __builtin_amdgcn_mfma_f32_32x32x16_bf16(v1, pf, o1, 0, 0, 0);
        }
        if (__all(R < -104.f)) break;
        cur = nxt;
    }
#pragma unroll
    for (int g = 0; g < 4; ++g) {
        u32x2 w0, w1;
        w0.x = cvtpk(o0[4 * g], o0[4 * g + 1]); w0.y = cvtpk(o0[4 * g + 2], o0[4 * g + 3]);
        w1.x = cvtpk(o1[4 * g], o1[4 * g + 1]); w1.y = cvtpk(o1[4 * g + 2], o1[4 * g + 3]);
        if (!DRY || R == 1234.56789f) { *(u32x2*)(qrow + 8 * g + 4 * hi) = w0; *(u32x2*)(qrow + 32 + 8 * g + 4 * hi) = w1; }
    }
}

namespace hg {
constexpr int STR = 272, OFF_QF = 0, OFF_KF = 16 * STR, OFF_KFT = 2 * 16 * STR, OFF_VT = OFF_KFT + 128 * 32, OFF_D = OFF_VT + 32 * 32, BUFB = OFF_D + 512;
constexpr int OFF_S = 2 * BUFB, SB = 32 * STR, OFF_O = OFF_S + 2 * SB, TOTAL = OFF_O + 8 * 16 * 64;
struct Raw { unsigned q[4], f[4], v[4]; };
__device__ __forceinline__ void load_raw(Raw& R, const bf16_t* qsrc, const bf16_t* fsrc, const bf16_t* vsrc, int step, bool isv) {
    const size_t o = (size_t)step * 16 * PW;
#pragma unroll
    for (int i = 0; i < 4; ++i) { R.q[i] = *(const unsigned*)(qsrc + o + (size_t)i * PW); R.f[i] = *(const unsigned*)(fsrc + o + (size_t)i * PW); R.v[i] = *(const unsigned*)(vsrc + o + (size_t)i * PW); }
}
__device__ __forceinline__ void prep(const Raw& Rin, LAS unsigned char* buf, int lane, int kch, int tq, bool isv, int vv, int vtq) {
    Raw R = Rin; const bool kodd = kch & 1, vodd = vv & 1;
#pragma unroll
    for (int i = 0; i < 4; ++i) { asm volatile("" : "+v"(R.q[i])); asm volatile("" : "+v"(R.f[i])); asm volatile("" : "+v"(R.v[i])); }
    float qv[4], kk[4], c[4]; float run = 0.f;
#pragma unroll
    for (int i = 0; i < 4; ++i) {
        qv[i] = __uint_as_float(kodd ? (R.q[i] & 0xffff0000u) : (R.q[i] << 16));
        const float l2 = __uint_as_float(kodd ? (R.f[i] & 0xffff0000u) : (R.f[i] << 16));
        kk[i] = 1.f - __builtin_amdgcn_exp2f(l2);
        run += l2; c[i] = run;
    }
    const float p1 = __shfl(run, (lane - 16) & 63), p2 = __shfl(run, (lane - 32) & 63), p3 = __shfl(run, (lane - 48) & 63);
    const float off = (tq >= 1 ? p1 : 0.f) + (tq >= 2 ? p2 : 0.f) + (tq >= 3 ? p3 : 0.f);
    const float btot = __shfl(off + run, 48 + (lane & 15));
    unsigned short kf[4];
#pragma unroll
    for (int i = 0; i < 4; ++i) {
        const float bt = off + c[i];
        const float qf = qv[i] * __builtin_amdgcn_exp2f(bt), kfv = kk[i] * __builtin_amdgcn_exp2f(-bt);
        const unsigned pk = cvtpk(qf, kfv);
        *(LAS unsigned short*)(buf + OFF_QF + (4 * tq + i) * STR + kch * 2) = (unsigned short)(pk & 0xffffu);
        kf[i] = (unsigned short)(pk >> 16);
        *(LAS unsigned short*)(buf + OFF_KF + (4 * tq + i) * STR + kch * 2) = kf[i];
    }
    *(LAS u32x2*)(buf + OFF_KFT + kch * 32 + tq * 8) = (u32x2){(unsigned)kf[0] | ((unsigned)kf[1] << 16), (unsigned)kf[2] | ((unsigned)kf[3] << 16)};
    if (tq == 0) *(LAS float*)(buf + OFF_D + kch * 4) = __builtin_amdgcn_exp2f(btot);
    if (isv) { unsigned v0 = vodd ? R.v[0] >> 16 : R.v[0] & 0xffffu, v1 = vodd ? R.v[1] >> 16 : R.v[1] & 0xffffu, v2 = vodd ? R.v[2] >> 16 : R.v[2] & 0xffffu, v3 = vodd ? R.v[3] >> 16 : R.v[3] & 0xffffu;
        *(LAS u32x2*)(buf + OFF_VT + vv * 32 + vtq * 8) = (u32x2){v0 | (v1 << 16), v2 | (v3 << 16)}; }
}
}
template <bool DRY> __device__ __forceinline__ void hgrn_unit(LAS unsigned char* lds, int b, int h, int vs, int layer, bf16_t* Pm, const float* lbraw) {
    using namespace hg;
    const int tid = otid(), lane = tid & 63; const int wid = __builtin_amdgcn_readfirstlane(tid >> 6);
    const size_t tok0 = (size_t)b * SEQ;
    const int kl = lane & 15, tq = lane >> 4, kch = 16 * wid + kl;
    (void)layer; (void)lbraw;
    const bf16_t* qsrc = Pm + (tok0 + 4 * tq) * PW + PC_HQ + h * 128 + (kch & ~1);
    const bf16_t* fsrc = Pm + (tok0 + 4 * tq) * PW + PC_HF + h * 128 + (kch & ~1);
    const bool isv = tid < 128; const int vv = tid & 31, vtq = (tid >> 5) & 3;
    const bf16_t* vsrc = Pm + (tok0 + 4 * vtq) * PW + PC_HI + h * 128 + vs * 32 + (vv & ~1);
    constexpr int NSTEP = SEQ / 16;
    for (int i = tid; i < SB / 4; i += NTHREADS) ((LAS unsigned*)(lds + OFF_S + SB))[i] = 0u;
    Raw ra, rb;
    load_raw(ra, qsrc, fsrc, vsrc, 0, isv);
    prep(ra, lds, lane, kch, tq, isv, vv, vtq);
    load_raw(ra, qsrc, fsrc, vsrc, 1, isv); load_raw(rb, qsrc, fsrc, vsrc, 2, isv);
    f32x16 sacc = {};
    const int c16 = lane & 15, kq = lane >> 4, r32 = lane & 31, hh = lane >> 5;
    __syncthreads();
#define HG_STEP(n, RR) do { \
        LAS unsigned char* cur = lds + (n & 1) * BUFB; LAS unsigned char* nxt = lds + ((n + 1) & 1) * BUFB; \
        if (n + 1 < NSTEP) { prep(RR, nxt, lane, kch, tq, isv, vv, vtq); load_raw(RR, qsrc, fsrc, vsrc, (n + 3 < NSTEP) ? n + 3 : NSTEP - 1, isv); } \
        if (wid < 4) {           \
            const bf16x8 a = *(const LAS bf16x8*)(cur + OFF_KFT + (32 * wid + r32) * 32 + 16 * hh); \
            const bf16x8 bb = *(const LAS bf16x8*)(cur + OFF_VT + r32 * 32 + 16 * hh); \
            sacc = __builtin_amdgcn_mfma_f32_32x32x16_bf16(a, bb, sacc, 0, 0, 0); \
            LAS unsigned char* sdst = lds + OFF_S + (n & 1) * SB + r32 * STR + (32 * wid + 4 * hh) * 2; \
_Pragma("unroll") \
            for (int g = 0; g < 4; ++g) { \
                const f32x4 dv = *(const LAS f32x4*)(cur + OFF_D + (32 * wid + 8 * g + 4 * hh) * 4); \
_Pragma("unroll") \
                for (int i = 0; i < 4; ++i) sacc[4 * g + i] *= dv[i]; \
                *(LAS u32x2*)(sdst + 16 * g) = (u32x2){cvtpk(sacc[4 * g], sacc[4 * g + 1]), cvtpk(sacc[4 * g + 2], sacc[4 * g + 3])}; \
            } \
        } else if (wid < 6) {    \
            const int vt = wid - 4; \
            LAS unsigned char* sprev = lds + OFF_S + ((n + 1) & 1) * SB; \
            bf16x8 qfr[4]; f32x4 at = {0.f, 0.f, 0.f, 0.f}; \
_Pragma("unroll") \
            for (int c = 0; c < 4; ++c) { \
                qfr[c] = *(const LAS bf16x8*)(cur + OFF_QF + c16 * STR + (32 * c + 8 * kq) * 2); \
                const bf16x8 kfr = *(const LAS bf16x8*)(cur + OFF_KF + c16 * STR + (32 * c + 8 * kq) * 2); \
                at = __builtin_amdgcn_mfma_f32_16x16x32_bf16(kfr, qfr[c], at, 0, 0, 0); \
            } \
_Pragma("unroll") \
            for (int r = 0; r < 4; ++r) at[r] = (4 * kq + r <= c16) ? at[r] : 0.f; \
            const u32x4 pw = (u32x4){cvtpk(at[0], at[1]), cvtpk(at[2], at[3]), 0u, 0u}; \
            const u32x2 vlo = *(const LAS u32x2*)(cur + OFF_VT + (16 * vt + c16) * 32 + kq * 8); \
            const u32x4 vw = (u32x4){vlo.x, vlo.y, 0u, 0u}; \
            f32x4 o = {0.f, 0.f, 0.f, 0.f}; \
            o = __builtin_amdgcn_mfma_f32_16x16x32_bf16(__builtin_bit_cast(bf16x8, vw), __builtin_bit_cast(bf16x8, pw), o, 0, 0, 0); \
_Pragma("unroll") \
            for (int c = 0; c < 4; ++c) { \
                const bf16x8 sa = *(const LAS bf16x8*)(sprev + (16 * vt + c16) * STR + (32 * c + 8 * kq) * 2); \
                o = __builtin_amdgcn_mfma_f32_16x16x32_bf16(sa, qfr[c], o, 0, 0, 0); \
            } \
            const u32x2 ow = (u32x2){cvtpk(o[0], o[1]), cvtpk(o[2], o[3])}; \
            *(LAS u32x2*)(lds + OFF_O + (((n) & 7) * 16 + c16) * 64 + (16 * vt + 4 * kq) * 2) = ow; \
        } \
        LDS_BARRIER(); } while (0)
#pragma unroll 1
    for (int g8 = 0; g8 < NSTEP; g8 += 8) {
#pragma unroll 1
        for (int n2 = g8; n2 < g8 + 8; n2 += 2) {
            { const int n = n2; HG_STEP(n, ra); }
            { const int n = n2 + 1; HG_STEP(n, rb); }
        }
        {
            const int row = tid >> 2, chk = tid & 3;
            const u32x4 ov = *(const LAS u32x4*)(lds + OFF_O + row * 64 + chk * 16);
            if (!DRY || ov.x == 0x12345678u) *(u32x4*)(Pm + (tok0 + (size_t)g8 * 16 + row) * PW + PC_HI + h * 128 + vs * 32 + chk * 8) = ov;
            __builtin_amdgcn_s_waitcnt(0x0F70);
            LDS_BARRIER();
        }
    }
#undef HG_STEP
    __syncthreads();
}
__device__ __forceinline__ void hgrn_finish(bf16_t* Pm, const float* normw) {
    const int tid = otid(); const int lane = tid & 63, wid = tid >> 6;
    const int gw = blockIdx.x * NWAVES + wid, NGW = gridDim.x * NWAVES;
    f32x4 w0 = *(const f32x4*)(normw + lane * 8), w1 = *(const f32x4*)(normw + lane * 8 + 4);
    for (int t = gw; t < T; t += NGW) {
        bf16_t* op = Pm + (size_t)t * PW + PC_HI + lane * 8; const bf16_t* gp = Pm + (size_t)t * PW + PC_HG + lane * 8;
        f32x4 a, b, g0, g1; unpack8(*(const u32x4*)op, a, b); unpack8(*(const u32x4*)gp, g0, g1);
        float ss = (a[0] * a[0] + a[1] * a[1]) + (a[2] * a[2] + a[3] * a[3]) + (b[0] * b[0] + b[1] * b[1]) + (b[2] * b[2] + b[3] * b[3]);
        ss += __shfl_xor(ss, 1); ss += __shfl_xor(ss, 2); ss += __shfl_xor(ss, 4); ss += __shfl_xor(ss, 8);
        const float rs = __builtin_amdgcn_rsqf(ss * (1.f / 128.f) + EPS);
#pragma unroll
        for (int j = 0; j < 4; ++j) { a[j] = a[j] * rs * w0[j] * siluf_(g0[j]); b[j] = b[j] * rs * w1[j] * siluf_(g1[j]); }
        *(u32x4*)op = pack8(a, b);
    }
}


#define XB_TMO      128
#define XB_XCNT(j)  (256  + 64 * (j))
#define XB_XSUB(j)  (1280 + 64 * (j))
#define XB_XGEN(j)  (2304 + 64 * (j))
#define XB_TOP      3328
#define XB_TOPGEN   3392
#define XCD_BAR_WORDS 3456
#define XB_SPIN_CAP (1u << 22)
__device__ __forceinline__ unsigned xb_ld(unsigned* p)              { return __hip_atomic_load(p, __ATOMIC_RELAXED, __HIP_MEMORY_SCOPE_AGENT); }
__device__ __forceinline__ unsigned xb_add(unsigned* p, unsigned v) { return __hip_atomic_fetch_add(p, v, __ATOMIC_RELAXED, __HIP_MEMORY_SCOPE_AGENT); }
__device__ __forceinline__ unsigned xb_xcc_id() { return (unsigned)__builtin_amdgcn_s_getreg((3 << 11) | 20) & 0xFu; }
#define XB_SPIN(cond, bar) do { unsigned _sp = 0; while (cond) { __builtin_amdgcn_s_sleep(1); \
    if ((++_sp & 255u) == 0u) { if (xb_ld(&(bar)[XB_TMO])) break; if (_sp > XB_SPIN_CAP) { atomicAdd(&(bar)[XB_TMO], 1u); break; } } } } while (0)
struct XcdBarrier { unsigned* bar; unsigned x; volatile LAS unsigned* st; };
__device__ __forceinline__ XcdBarrier xcd_barrier_post(unsigned* bar, volatile LAS unsigned* st) {
    XcdBarrier b; b.bar = bar; b.x = xb_xcc_id(); b.st = st;
    if (threadIdx.x == 0) (void)xb_add(&bar[XB_XCNT(b.x)], 1u);
    return b;
}
__device__ __forceinline__ void xcd_barrier_complete(unsigned* bar, unsigned x, unsigned& nloc, unsigned& nx) {
    const unsigned G = gridDim.x * gridDim.y * gridDim.z;
    unsigned sum, cnt, mine, sp = 0u;
    for (;;) {
        sum = 0u; cnt = 0u; mine = 0u;
#pragma unroll
        for (unsigned j = 0; j < 16; ++j) { const unsigned c = xb_ld(&bar[XB_XCNT(j)]); sum += c; cnt += (c > 0u) ? 1u : 0u; mine = (j == x) ? c : mine; }
        if (sum == G) break;
        __builtin_amdgcn_s_sleep(1);
        if ((++sp & 255u) == 0u) { if (xb_ld(&bar[XB_TMO])) break; if (sp > XB_SPIN_CAP) { atomicAdd(&bar[XB_TMO], 1u); break; } }
    }
    nloc = mine > 0u ? mine : 1u; nx = cnt > 0u ? cnt : 1u;
}
__device__ __forceinline__ void xcd_barrier(const XcdBarrier& b) {
    asm volatile("s_waitcnt vmcnt(0)" ::: "memory");
    __syncthreads();
    if (threadIdx.x == 0) {
        unsigned* bar = b.bar;
        __builtin_amdgcn_s_waitcnt(0);
        unsigned nloc = b.st[0], nx = b.st[1];
        if (nloc == 0u) { xcd_barrier_complete(bar, b.x, nloc, nx); b.st[0] = nloc; b.st[1] = nx; }
        const unsigned old = xb_add(&bar[XB_XSUB(b.x)], 1u);
        const unsigned gen = old / nloc;
        if (old + 1u == (gen + 1u) * nloc) {
            __builtin_amdgcn_fence(__ATOMIC_RELEASE, "agent");
            asm volatile("s_waitcnt vmcnt(0)" ::: "memory");
            const unsigned og = xb_add(&bar[XB_TOP], 1u);
            const unsigned tg = og / nx;
            if (og + 1u == (tg + 1u) * nx) xb_add(&bar[XB_TOPGEN], 1u);
            else XB_SPIN(xb_ld(&bar[XB_TOPGEN]) == tg, bar);
            __builtin_amdgcn_fence(__ATOMIC_ACQUIRE, "agent");
            xb_add(&bar[XB_XGEN(b.x)], 1u);
            asm volatile("s_waitcnt vmcnt(0)" ::: "memory");
        } else {
            XB_SPIN(xb_ld(&bar[XB_XGEN(b.x)]) == gen, bar);
            __builtin_amdgcn_fence(__ATOMIC_ACQUIRE, "agent");
            asm volatile("s_waitcnt vmcnt(0)" ::: "memory");
        }
    }
    __syncthreads();
}

__global__ void __launch_bounds__(NTHREADS, 2) fwd_megakernel(Params Pkern) {
    extern __shared__ __attribute__((aligned(16))) unsigned char lds_raw[];
    LAS unsigned char* lds = (LAS unsigned char*)lds_raw;
    cg::grid_group grid = cg::this_grid();
    const int ph_lo = Pkern.ph_lo, ph_hi = Pkern.ph_hi;
    int ph = 0;
    if (threadIdx.x < 2) ((volatile LAS unsigned*)(lds + 131072))[threadIdx.x] = 0u;
    __syncthreads();
    XcdBarrier xbar; xbar.bar = (unsigned*)(Pkern.ws + WS_BAR); xbar.x = 0; xbar.st = (volatile LAS unsigned*)(lds + 131072);
    if (ph_hi - ph_lo > 1) xbar = xcd_barrier_post((unsigned*)(Pkern.ws + WS_BAR), (volatile LAS unsigned*)(lds + 131072));
#define PH_ON (ph_lo <= ph && ph < ph_hi)
#define PM(k) ((PHASE_MASK >> (k)) & 1)
#define PH_END do { if (ph_lo <= ph && ph + 1 < ph_hi) { if (ph == 0) grid.sync(); else xcd_barrier(xbar); } ++ph; } while (0)
#define WSP(off) (ws + (off))
#define SETUP KPtr Pp = kparams(); unsigned char* ws = Pp->ws; const int tid = otid(), lane = tid & 63, wid = tid >> 6; const int gw = blockIdx.x * NWAVES + wid, NGW = gridDim.x * NWAVES; \
    float* RS = (float*)WSP(WS_RS); bf16_t* wb = (bf16_t*)WSP(WS_W); bf16_t* HB = (bf16_t*)WSP(WS_HB); bf16_t* HBALT = (bf16_t*)WSP(WS_HBALT); bf16_t* PB = (bf16_t*)WSP(WS_P); bf16_t* HID = PB; \
    bf16_t* QB = (bf16_t*)WSP(WS_Q); bf16_t* KN = (bf16_t*)WSP(WS_KN); bf16_t* VT = (bf16_t*)WSP(WS_VT); bf16_t* SBVT = (bf16_t*)WSP(WS_SBVT); bf16_t* MERGED = KN; bf16_t* PBF = KN; \
    bf16_t* TMPG = PB + PC_SBK; bf16_t* TMP2 = (bf16_t*)WSP(WS_TMP2); float* ROPE = (float*)WSP(WS_ROPE); float* OUT = Pp->out; \
    (void)lane; (void)gw; (void)NGW; (void)RS; (void)wb; (void)HB; (void)HBALT; (void)HID; (void)QB; (void)KN; (void)VT; (void)SBVT; (void)MERGED; (void)PBF; (void)TMPG; (void)TMP2; (void)ROPE; (void)OUT;
#define LSETUP float* rs0 = RS + (size_t)(4 * layer) * T; float* rs1 = rs0 + T; float* rs2 = rs1 + T; float* rs3 = rs2 + T; float* rs4 = rs3 + T; \
    float* rsq = RS + (size_t)(9 + layer) * T; float* rskv = RS + (size_t)(11 + layer) * T; (void)rs0; (void)rs1; (void)rs2; (void)rs3; (void)rs4; (void)rsq; (void)rskv;

    if (PH_ON && PM(0)) for (int rep_ = 0; rep_ < ((DUPMASK & 32) ? 2 : 1); ++rep_) {
        SETUP
        convert_weights(lds, 0, 0, 16);
        convert_weights(lds, 1, 14, 16);
        for (int i = blockIdx.x * NTHREADS + tid; i < 12 * T; i += gridDim.x * NTHREADS) RS[T + i] = 0.f;
        if (blockIdx.x == 0) { const float* lbraw = Pp->lbraw; float* lbt = (float*)WSP(WS_LBT);
            { const float l0 = lbraw[tid], l1 = lbraw[512 + tid]; float lb = 1.f / (1.f + expf(l0 - l1)); lb = fminf(fmaxf(lb, 0.f), 1.f - 1e-6f); lbt[tid] = 0.f; lbt[512 + tid] = lb; } }
        { const int* pos = Pp->pos;
          for (int i = blockIdx.x * NTHREADS + tid; i < 16 * T; i += gridDim.x * NTHREADS) { float c_, s_; rope_table_entry(pos[i >> 4], i & 15, c_, s_); ROPE[i] = c_; ROPE[(size_t)T * 16 + i] = s_; } }
        const float* X = Pp->x;
        for (int m = gw * 2; m < T; m += NGW * 2) {
            f32x4 va[2][4];
#pragma unroll
            for (int rr = 0; rr < 2; ++rr) { const f32x4* xr = (const f32x4*)(X + (size_t)(m + rr) * DM) + lane * 2;
#pragma unroll
                for (int j = 0; j < 2; ++j) { va[rr][2 * j] = xr[128 * j]; va[rr][2 * j + 1] = xr[128 * j + 1]; } }
#pragma unroll
            for (int rr = 0; rr < 2; ++rr) { float ss = 0.f;
#pragma unroll
                for (int j = 0; j < 2; ++j) { const f32x4 a = va[rr][2 * j], b = va[rr][2 * j + 1];
                    *(u32x4*)(HB + (size_t)(m + rr) * DM + 512 * j + lane * 8) = pack8(a, b);
                    ss += (a[0] * a[0] + a[1] * a[1]) + (a[2] * a[2] + a[3] * a[3]) + (b[0] * b[0] + b[1] * b[1]) + (b[2] * b[2] + b[3] * b[3]); }
#pragma unroll
                for (int o = 1; o < 64; o <<= 1) ss += __shfl_xor(ss, o);
                if (lane == 0) RS[m + rr] = ss; }
        }
    }
    PH_END;

#pragma unroll 1
    for (int layer = 0; layer < DEPTH; ++layer) {
        if (PH_ON && PM(1)) { SETUP LSETUP const bf16_t* hin = layer == 0 ? HB : HBALT; pg8::EpiSwiglu E{HID, rs0}; if (DUPMASK & 16) run_gemm(lds, hin, DM, wb + WO_A_IN, DM, T, 5632, DM, E); run_gemm(lds, hin, DM, wb + WO_A_IN, DM, T, 5632, DM, E); }
        if ((DUPMASK & 8) && ph_hi - ph_lo > 1) { xcd_barrier(xbar); xcd_barrier(xbar); xcd_barrier(xbar); xcd_barrier(xbar); xcd_barrier(xbar); }
        PH_END;
        if (PH_ON && PM(2)) for (int rep_ = ((DUPMASK & 512) ? 0 : 1); rep_ < 2; ++rep_) { SETUP LSETUP pg8::EpiResid<false> E{layer == 0 ? Pp->x : (const float*)OUT, OUT, HB, rs1, 0.5f, nullptr, nullptr, rep_ == 0}; run_gemm(lds, HID, FF, wb + WO_A_OUT, FF, T, DM, FF, E); }
        PH_END;
        if (PH_ON && PM(3)) {
            if (PM(17)) for (int rep_ = ((DUPMASK & 1024) ? 0 : 1); rep_ < 2; ++rep_) { SETUP LSETUP pg8::EpiInproj E{PB, rs1, rsq, rskv, ROPE, (const float*)WSP(WS_LBT) + layer * 512, rep_ == 0}; run_gemm(lds, HB, DM, wb + WO_IN, DM, T, 3840, DM, E); }
            if (PM(18)) { SETUP LSETUP pg8::EpiStoreCol E{SBVT, T, rs1, 1.f / 1024.f}; run_gemm(lds, wb + WO_SBV, DM, HB, DM, 512, T, DM, E); }
        }
        PH_END;
        if (PH_ON && PM(4)) {
            if (PM(12)) { SETUP const float* lbraw = Pp->lbraw; if (DUPMASK & 1) for (int u = blockIdx.x; u < 256; u += gridDim.x) hgrn_unit<true>(lds, u >> 4, (u >> 2) & 3, u & 3, layer, PB, lbraw);
              for (int u = blockIdx.x; u < 256; u += gridDim.x) hgrn_unit<false>(lds, u >> 4, (u >> 2) & 3, u & 3, layer, PB, lbraw); }
            for (int rep_ = 0; rep_ < ((DUPMASK & 128) ? 2 : 1); ++rep_) {
            if (PM(13)) { SETUP LSETUP pg8::EpiQup E{QB, rsq, ROPE}; run_gemm(lds, PB + PC_CQ, PW, wb + WO_UQ, 384, T, 768, 384, E); }
            if (PM(14)) { SETUP LSETUP pg8::EpiStore E{KN, 512, rskv, 1.f / 256.f, 0}; run_gemm(lds, PB + PC_CKV, PW, wb + WO_UK, 256, T, 512, 256, E); }
            if (PM(15)) { SETUP LSETUP pg8::EpiStoreCol E{VT, T, rskv, 1.f / 256.f}; run_gemm(lds, wb + WO_UV, 256, PB + PC_CKV, PW, 512, T, 256, E); }
            }
            if (PM(16)) { SETUP if (DUPMASK & 4) for (int u = gw; u < NBATCH * 8 * 64; u += NGW) sb_unit<true>(u >> 9, (u >> 6) & 7, u & 63, PB, SBVT);
              for (int u = gw; u < NBATCH * 8 * 64; u += NGW) sb_unit<false>(u >> 9, (u >> 6) & 7, u & 63, PB, SBVT); }
        }
        PH_END;
        if (PH_ON && PM(5)) {
            { SETUP
            for (int c = blockIdx.x; c < 256; c += gridDim.x) {
                const int bh = c >> 1;
#pragma unroll 1
                for (int i = 0; i < 4; ++i) { const int s = (c & 1) * 2 + (i >> 1); const int qb = (i & 1) ? 7 - s : s; if (DUPMASK & 2) mla_unit<true>(lds, bh >> 3, bh & 7, qb, QB, KN, PB, VT, QB); mla_unit<false>(lds, bh >> 3, bh & 7, qb, QB, KN, PB, VT, QB); }
            } }
            { SETUP hgrn_finish(PB, Pp->hg_norm + layer * 512); }
        }
        PH_END;
        if (PH_ON && PM(6)) {
#pragma unroll 1
            for (int i_ = 0; i_ < ((DUPMASK & 64) ? 6 : 3); ++i_) { const int i = i_ % 3;
                { SETUP LSETUP pg8::EpiStore E{TMPG, PW, rs1, 1.f / 1024.f, 1}; run_gemm(lds, HB, DM, wb + WO_GATE + (size_t)i * 1024 * 1024, DM, T, DM, DM, E); }
                { SETUP const bf16_t* ya = i == 0 ? QB : (i == 1 ? PB + PC_SBQ : PB + PC_HI); const int lda = i == 0 ? 768 : PW;
                  pg8::EpiBranch E{MERGED, TMPG, PW, i == 0}; run_gemm(lds, ya, lda, wb + WO_BR + (size_t)i * 1024 * 512, 512, T, DM, 512, E); }
            }
        }
        PH_END;
        if (PH_ON && PM(7)) for (int rep_ = ((DUPMASK & 2048) ? 0 : 1); rep_ < 2; ++rep_) { SETUP LSETUP pg8::EpiResid<false> E{OUT, OUT, HB, rs2, 1.0f, nullptr, nullptr, rep_ == 0}; run_gemm(lds, MERGED, DM, wb + WO_OUT, DM, T, DM, DM, E); }
        PH_END;
        if (PH_ON && PM(8)) { SETUP LSETUP pg8::EpiSwiglu E{HID, rs2}; run_gemm(lds, HB, DM, wb + WO_B_IN, DM, T, 5632, DM, E); }
        PH_END;
        if (PH_ON && PM(9)) {
            { SETUP LSETUP pg8::EpiResid<false> E{OUT, OUT, HB, rs3, 0.5f, nullptr, nullptr, 0}; run_gemm(lds, HID, FF, wb + WO_B_OUT, FF, T, DM, FF, E); }
            { SETUP const float* pp = Pp->p + (size_t)layer * T * 256;
              for (size_t i = (size_t)blockIdx.x * NTHREADS + tid; i < (size_t)T * 256 / 8; i += (size_t)gridDim.x * NTHREADS) {
                const f32x4 a = *(const f32x4*)(pp + i * 8), b = *(const f32x4*)(pp + i * 8 + 4); *(u32x4*)(PBF + i * 8) = pack8(a, b); } }
        }
        PH_END;
        if (PH_ON && PM(10)) {
            for (int rep_ = ((DUPMASK & 4096) ? 0 : 1); rep_ < 2; ++rep_) {
            if (PM(19)) { SETUP bf16_t* wple = (bf16_t*)WSP(WS_WPLE + (size_t)layer * WPLE_STRIDE); pg8::EpiStore E{TMP2, DM, nullptr, 1.f, 0}; run_gemm(lds, PBF, 256, wple + (size_t)1024 * 1024, 256, T, DM, 256, E); }
            if (PM(20)) { SETUP LSETUP bf16_t* wple = (bf16_t*)WSP(WS_WPLE + (size_t)layer * WPLE_STRIDE); pg8::EpiResid<true> E{OUT, OUT, HBALT, rs4, 1.0f, TMP2, rs3, rep_ == 0}; run_gemm(lds, HB, DM, wple, DM, T, DM, DM, E); }
            }
            if (PM(21)) if (layer + 1 < DEPTH) { __syncthreads(); convert_weights(lds, layer + 1, 0, 14); if (DUPMASK & 256) convert_weights(lds, layer + 1, 0, 14); }
        }
        PH_END;
    }
    if (PH_ON && PM(11)) {
        SETUP
        const float* rsf = RS + (size_t)8 * T; const float* fw = Pp->final_norm;
        f32x4 w[4];
#pragma unroll
        for (int j = 0; j < 4; ++j) w[j] = *((const f32x4*)fw + lane + 64 * j);
        for (int m = gw; m < T; m += NGW) {
            const float t = rstd_of(rsf[m], 1.f / 1024.f); f32x4* orow = (f32x4*)(OUT + (size_t)m * DM) + lane;
#pragma unroll
            for (int j = 0; j < 4; ++j) orow[64 * j] = orow[64 * j] * t * w[j];
        }
    }
#undef PH_ON
#undef PH_END
}

constexpr int N_PHASES = 1 + 10 * DEPTH + 1;
#ifndef MK_PER_PHASE
#define MK_PER_PHASE 0
#endif

extern "C" void kernel_launch(void* const* d_in, const int* in_sizes, int n_in, void* d_out, int out_size, void* d_ws, size_t ws_size, hipStream_t stream) {
    static int grid = 0;
    if (grid == 0) {
        if (n_in != 25 || ws_size < WS_END) { fprintf(stderr, "kernel_launch: unexpected n_in %d / ws %zu\n", n_in, ws_size); grid = -1; return; }
        int dev = 0, cus = 0, per_cu = 0;
        hipGetDevice(&dev); hipDeviceGetAttribute(&cus, hipDeviceAttributeMultiprocessorCount, dev);
        hipFuncSetAttribute((const void*)fwd_megakernel, hipFuncAttributeMaxDynamicSharedMemorySize, LDS_BYTES);
        hipOccupancyMaxActiveBlocksPerMultiprocessor(&per_cu, (const void*)fwd_megakernel, NTHREADS, LDS_BYTES);
        if (per_cu < 1) per_cu = 1;
        (void)hipGetLastError();
        grid = cus * 1;
        if (grid <= 0) grid = 256;
    }
    if (grid < 0) return;
    Params p{};
    const float** fp = (const float**)&p;
    (void)fp;
    p.x = (const float*)d_in[0]; p.p = (const float*)d_in[1]; p.pos = (const int*)d_in[2];
    p.ffn_a_norm = (const float*)d_in[3]; p.ffn_a_w_in = (const float*)d_in[4]; p.ffn_a_w_out = (const float*)d_in[5]; p.mix_norm = (const float*)d_in[6]; p.w_in = (const float*)d_in[7];
    p.mla_q_norm = (const float*)d_in[8]; p.mla_w_uq = (const float*)d_in[9]; p.mla_kv_norm = (const float*)d_in[10]; p.mla_w_ukv = (const float*)d_in[11]; p.lbraw = (const float*)d_in[12]; p.hg_norm = (const float*)d_in[13];
    p.w_br_mla = (const float*)d_in[14]; p.w_br_sb = (const float*)d_in[15]; p.w_br_hgrn = (const float*)d_in[16]; p.w_out = (const float*)d_in[17]; p.ffn_b_norm = (const float*)d_in[18]; p.ffn_b_w_in = (const float*)d_in[19]; p.ffn_b_w_out = (const float*)d_in[20];
    p.ple_norm = (const float*)d_in[21]; p.w_ple_gate = (const float*)d_in[22]; p.w_ple_proj = (const float*)d_in[23]; p.final_norm = (const float*)d_in[24];
    p.out = (float*)d_out; p.ws = (unsigned char*)d_ws;
#if MK_PER_PHASE
    for (int k = 0; k < N_PHASES; ++k) { p.ph_lo = k; p.ph_hi = k + 1; hipLaunchKernelGGL(fwd_megakernel, dim3(grid), dim3(NTHREADS), LDS_BYTES, stream, p); }
#else
    p.ph_lo = 0; p.ph_hi = N_PHASES;
    (void)hipMemsetAsync((unsigned char*)d_ws + WS_BAR, 0, XCD_BAR_WORDS * 4, stream);
    void* args[] = {&p};
    hipError_t e = hipLaunchCooperativeKernel((const void*)fwd_megakernel, dim3(grid), dim3(NTHREADS), args, LDS_BYTES, stream);
    if (e != hipSuccess) fprintf(stderr, "cooperative launch failed: %s (grid %d)\n", hipGetErrorString(e), grid);
#endif
}
```

```cpp
#include <hip/hip_runtime.h>
#include <hip/hip_cooperative_groups.h>
#include <cstdio>
#include <cstdint>
namespace cg = cooperative_groups;

#define LAS __attribute__((address_space(3)))
typedef unsigned short bf16_t;
typedef short bf16x8 __attribute__((ext_vector_type(8)));
typedef short s16x4 __attribute__((ext_vector_type(4)));
typedef float f32x4 __attribute__((ext_vector_type(4)));
typedef float f32x16 __attribute__((ext_vector_type(16)));
typedef unsigned u32x4 __attribute__((ext_vector_type(4)));
typedef unsigned u32x2 __attribute__((ext_vector_type(2)));
typedef float f32x2_t __attribute__((ext_vector_type(2)));
typedef __bf16 bf16x2_t __attribute__((ext_vector_type(2)));

constexpr int T = 32768, DM = 1024, FF = 2816, SEQ = 2048, NBATCH = 16, DEPTH = 2;
constexpr int PW = 3744;
constexpr int PC_CQ = 0, PC_CKV = 384, PC_SBQ = 640, PC_SBK = 1152, PC_HQ = 1664, PC_HF = 2176, PC_HI = 2688, PC_HG = 3200, PC_KR = 3712;
constexpr int NWAVES = 8, NTHREADS = 512;
constexpr int LDS_BYTES = 131072 + 1024;
constexpr float EPS = 1e-6f;
#ifndef DUPMASK
#define DUPMASK 0
#endif
#ifndef PHASE_MASK
#define PHASE_MASK 0xFFFFFFFFu
#endif

constexpr size_t MiB = (size_t)1 << 20;
constexpr size_t WS_RS = 0;
constexpr size_t WS_BAR = 2 * MiB;
constexpr size_t WS_LBT = 3 * MiB;
constexpr size_t WS_WPLE = 6 * MiB;
constexpr size_t WPLE_STRIDE = (size_t)(1024 * 1024 + 1024 * 256) * 2;
constexpr size_t WS_W = 11 * MiB;
constexpr size_t WS_HB = 65 * MiB;
constexpr size_t WS_P = 129 * MiB;
constexpr size_t WS_TMP2 = 305 * MiB;
constexpr size_t WS_Q = 363 * MiB;
constexpr size_t WS_KN = 411 * MiB;
constexpr size_t WS_VT = 443 * MiB;
constexpr size_t WS_SBVT = 475 * MiB;
constexpr size_t WS_HBALT = 427 * MiB;
constexpr size_t WS_ROPE = 507 * MiB;
constexpr size_t WS_END = 511 * MiB;
constexpr size_t WO_A_IN = 0;
constexpr size_t WO_A_OUT = WO_A_IN + (size_t)5632 * 1024;
constexpr size_t WO_IN = WO_A_OUT + (size_t)1024 * 2816;
constexpr size_t WO_SBV = WO_IN + (size_t)3840 * 1024;
constexpr size_t WO_GATE = WO_SBV + (size_t)512 * 1024;
constexpr size_t WO_UQ = WO_GATE + (size_t)3072 * 1024;
constexpr size_t WO_UK = WO_UQ + (size_t)768 * 384;
constexpr size_t WO_UV = WO_UK + (size_t)512 * 256;
constexpr size_t WO_BR = WO_UV + (size_t)512 * 256;
constexpr size_t WO_OUT = WO_BR + (size_t)3 * 1024 * 512;
constexpr size_t WO_B_IN = WO_OUT + (size_t)1024 * 1024;
constexpr size_t WO_B_OUT = WO_B_IN + (size_t)5632 * 1024;
constexpr size_t WO_END = WO_B_OUT + (size_t)1024 * 2816;
static_assert(WO_END * 2 <= 54 * MiB, "weights fit");

struct Params {
    const float* x; const float* p; const int* pos;
    const float* ffn_a_norm; const float* ffn_a_w_in; const float* ffn_a_w_out; const float* mix_norm; const float* w_in;
    const float* mla_q_norm; const float* mla_w_uq; const float* mla_kv_norm; const float* mla_w_ukv; const float* lbraw; const float* hg_norm;
    const float* w_br_mla; const float* w_br_sb; const float* w_br_hgrn; const float* w_out; const float* ffn_b_norm; const float* ffn_b_w_in; const float* ffn_b_w_out;
    const float* ple_norm; const float* w_ple_gate; const float* w_ple_proj; const float* final_norm;
    float* out; unsigned char* ws; int ph_lo, ph_hi;
};

__device__ __forceinline__ int otid() { int t = threadIdx.x; asm volatile("" : "+v"(t)); return t; }
typedef const __attribute__((address_space(4))) Params* KPtr;
__device__ __forceinline__ KPtr kparams() { KPtr p = (KPtr)__builtin_amdgcn_kernarg_segment_ptr(); asm volatile("" : "+s"(p)); return p; }
__device__ __forceinline__ unsigned cvtpk(float lo, float hi) { f32x2_t v = {lo, hi}; bf16x2_t b = __builtin_convertvector(v, bf16x2_t); return __builtin_bit_cast(unsigned, b); }
__device__ __forceinline__ float bflo(unsigned w) { return __uint_as_float(w << 16); }
__device__ __forceinline__ float bfhi(unsigned w) { return __uint_as_float(w & 0xffff0000u); }
__device__ __forceinline__ float rstd_of(float ss, float invn) { return __builtin_amdgcn_rsqf(ss * invn + EPS); }
__device__ __forceinline__ float sigmoidf_(float x) { return __builtin_amdgcn_rcpf(1.f + __expf(-x)); }
__device__ __forceinline__ float siluf_(float x) { return x * __builtin_amdgcn_rcpf(1.f + __expf(-x)); }
__device__ __forceinline__ u32x4 pack8(f32x4 a, f32x4 b) { u32x4 w; w.x = cvtpk(a[0], a[1]); w.y = cvtpk(a[2], a[3]); w.z = cvtpk(b[0], b[1]); w.w = cvtpk(b[2], b[3]); return w; }
__device__ __forceinline__ void unpack8(u32x4 w, f32x4& a, f32x4& b) { a = (f32x4){bflo(w.x), bfhi(w.x), bflo(w.y), bfhi(w.y)}; b = (f32x4){bflo(w.z), bfhi(w.z), bflo(w.w), bfhi(w.w)}; }
#define LDS_BARRIER() do { asm volatile("s_waitcnt lgkmcnt(0)" ::: "memory"); __builtin_amdgcn_s_barrier(); asm volatile("" ::: "memory"); } while (0)
__device__ __forceinline__ int crow(int r, int hi) { return (r & 3) + 8 * (r >> 2) + 4 * hi; }
__device__ __forceinline__ void rope8(f32x4& x1, f32x4& x2, const float* cs, const float* sn, int fq) {
    const f32x4 c = *(const f32x4*)(cs + 4 * fq), s = *(const f32x4*)(sn + 4 * fq);
    const f32x4 a = x1, b = x2;
    x1 = a * c - b * s; x2 = b * c + a * s;
}
__device__ __forceinline__ void rope_table_entry(int pos, int i, float& cs, float& sn) {
    const float inv = __builtin_amdgcn_exp2f(-(float)i * 0.8304820237218406f);
    const float ang = (float)pos * inv;
    double rv = (double)ang * 0.15915494309189535; rv -= floor(rv);
    const float fr = (float)rv;
    sn = __builtin_amdgcn_sinf(fr); cs = __builtin_amdgcn_cosf(fr);
}

namespace pg8 {
constexpr int BM = 256, BK = 64, HALF = 128, HTB = HALF * BK * 2, NXCD = 8, WGM = 8;
__device__ __forceinline__ int lds_byte(int r, int c) { const int st = (r >> 4) * 2 + (c >> 5), rr = r & 15, cc = c & 31, ob = rr * 64 + cc * 2; return st * 1024 + (ob ^ (((ob >> 9) & 1) << 5)); }
__device__ __forceinline__ void stage_rc(int b, int& R, int& C) { const int st = b / 1024, sb = b % 1024, swz = sb ^ (((sb >> 9) & 1) << 5); R = (st >> 1) * 16 + swz / 64; C = (st & 1) * 32 + (swz % 64) / 2; }
__device__ __forceinline__ int perm32(int rho) { const int n = rho >> 4, i = rho & 15; return 8 * (i >> 2) + 4 * n + (i & 3); }
struct Unit { int pm, pn; };
struct Gemm { const bf16_t* A; const bf16_t* Bt; int lda, ldb, M, N, K; };
struct StaticOrder {
    int nM, nN, nwg, G, c;
    __device__ __forceinline__ void init(int M, int N, int G_, int c_) { nM = M / BM; nN = N / BM; nwg = nM * nN; G = G_; c = c_; }
    __device__ __forceinline__ bool next(int i, Unit& u) const {
        const long L = (long)i * G + c; if (L >= nwg) return false;
        int wgid = (int)L; { const int q = nwg / NXCD, r = nwg % NXCD, xcd = wgid % NXCD, off = wgid / NXCD; wgid = (xcd < r ? xcd * (q + 1) : r * (q + 1) + (xcd - r) * q) + off; }
        const int nig = WGM * nN, gid = wgid / nig, fm = gid * WGM, gsz = (nM - fm) < WGM ? (nM - fm) : WGM;
        u.pm = fm + ((wgid % nig) % gsz); u.pn = (wgid % nig) / gsz; return true;
    }
};
template <class Epi>
__device__ __forceinline__ void gemm_phase(LAS unsigned char* lds, const Gemm g, const StaticOrder& S, const Epi& E) {
    int tid_ = threadIdx.x; asm volatile("" : "+v"(tid_));
    const int tid = tid_, wid = __builtin_amdgcn_readfirstlane(tid >> 6), lane = tid & 63, wr = wid >> 2, wc = wid & 3, fr = lane & 15, fq = lane >> 4;
    const int K = g.K, nt = K / BK;
    unsigned voffA[2], voffB[2];
#pragma unroll
    for (int i = 0; i < 2; ++i) { int R, C; stage_rc(tid * 16 + i * 8192, R, C); const int Rb = (R & ~31) + perm32(R & 31);
        voffA[i] = (unsigned)(R * g.lda + C) * 2u; voffB[i] = (unsigned)((64 * (Rb >> 5) + (Rb & 31)) * g.ldb + C) * 2u; }
    const size_t kstep = (size_t)(BK * 2);
    const size_t hstepA = (size_t)HALF * g.lda * 2, tstepA = 2 * hstepA;
    const size_t hstepB = (size_t)32 * g.ldb * 2, tstepB = (size_t)BM * g.ldb * 2;
    const unsigned ldsw = (unsigned)wid * 1024u;
    const int aoff = lds_byte(wr * 64 + fr, fq * 8), boff = lds_byte(wc * 32 + fr, fq * 8);
#define PG8_SA(b, h) (((b) * 2 + (h)) * HTB)
#define PG8_SB(b, h) ((4 + (b) * 2 + (h)) * HTB)
#define PG8_STAGE(bufoff, gbase, voff) do { _Pragma("unroll") for (int _i = 0; _i < 2; ++_i) \
        __builtin_amdgcn_global_load_lds((const unsigned*)((const char*)(gbase) + (voff)[_i]), (LAS unsigned*)(lds + (bufoff) + ldsw + _i * 8192), 16, 0, 0); } while (0)
#define PG8_LDA(dst, b, h) do { _Pragma("unroll") for (int m = 0; m < 4; ++m) _Pragma("unroll") for (int k = 0; k < 2; ++k) dst[m][k] = *(const LAS bf16x8*)(lds + PG8_SA(b, h) + aoff + m * 2048 + k * 1024); } while (0)
#define PG8_LDB(dst, b, h) do { _Pragma("unroll") for (int n = 0; n < 2; ++n) _Pragma("unroll") for (int k = 0; k < 2; ++k) dst[n][k] = *(const LAS bf16x8*)(lds + PG8_SB(b, h) + boff + n * 2048 + k * 1024); } while (0)
#define PG8_MMA(ai, bj, At, Bt) do { __builtin_amdgcn_s_setprio(1); _Pragma("unroll") for (int m = 0; m < 4; ++m) _Pragma("unroll") for (int n = 0; n < 2; ++n) _Pragma("unroll") for (int k = 0; k < 2; ++k) \
        acc[ai][bj][m][n] = __builtin_amdgcn_mfma_f32_16x16x32_bf16(Bt[n][k], At[m][k], acc[ai][bj][m][n], 0, 0, 0); __builtin_amdgcn_s_setprio(0); } while (0)
#define PG8_WAIT_V(n) asm volatile("s_waitcnt vmcnt(" #n ")" ::: "memory")
#define PG8_WAIT_L(n) asm volatile("s_waitcnt lgkmcnt(" #n ")" ::: "memory")
#define PG8_BAR __builtin_amdgcn_s_barrier()
#define PG8_SCHED __builtin_amdgcn_sched_barrier(0)
    Unit cur, nxt; int ui = 0;
    if (!S.next(0, cur)) return;
    f32x4 acc[2][2][4][2];
#pragma unroll
    for (int a = 0; a < 2; ++a)
#pragma unroll
        for (int b = 0; b < 2; ++b)
#pragma unroll
            for (int m = 0; m < 4; ++m)
#pragma unroll
                for (int n = 0; n < 2; ++n) acc[a][b][m][n] = (f32x4){0.f, 0.f, 0.f, 0.f};
    bf16x8 At[4][2], B0[2][2], B1[2][2];
    const char* cA = (const char*)g.A + (size_t)cur.pm * tstepA; const char* cB = (const char*)g.Bt + (size_t)cur.pn * tstepB;
    PG8_STAGE(PG8_SB(0, 0), cB, voffB); PG8_STAGE(PG8_SB(0, 1), cB + hstepB, voffB); PG8_STAGE(PG8_SA(0, 0), cA, voffA); PG8_STAGE(PG8_SA(0, 1), cA + hstepA, voffA);
    if (wr == 1) PG8_BAR;
    PG8_WAIT_V(2); PG8_BAR;
    PG8_STAGE(PG8_SB(1, 0), cB + kstep, voffB); PG8_STAGE(PG8_SA(1, 0), cA + kstep, voffA); PG8_STAGE(PG8_SB(1, 1), cB + hstepB + kstep, voffB);
    PG8_WAIT_V(6); PG8_BAR;
    for (;;) {
        const bool has_next = S.next(ui + 1, nxt);
        const char* nA = has_next ? (const char*)g.A + (size_t)nxt.pm * tstepA : cA; const char* nB = has_next ? (const char*)g.Bt + (size_t)nxt.pn * tstepB : cB;
#pragma unroll 1
        for (int t = 0; t < nt; t += 2) {
            const bool last = (t == nt - 2);
            const char* a1 = cA + (size_t)(t + 1) * kstep;
            const char* a2 = last ? nA : cA + (size_t)(t + 2) * kstep; const char* b2 = last ? nB : cB + (size_t)(t + 2) * kstep;
            const char* a3 = a2 + kstep; const char* b3 = b2 + kstep;
            PG8_LDB(B0, 0, 0); PG8_LDB(B1, 0, 1); PG8_SCHED; PG8_LDA(At, 0, 0); PG8_STAGE(PG8_SA(1, 1), a1 + hstepA, voffA);
            PG8_WAIT_V(8); PG8_WAIT_L(0); PG8_BAR; PG8_MMA(0, 0, At, B0); PG8_MMA(0, 1, At, B1); PG8_BAR; PG8_SCHED;
            PG8_LDA(At, 0, 1); PG8_STAGE(PG8_SB(0, 0), b2, voffB); PG8_STAGE(PG8_SB(0, 1), b2 + hstepB, voffB); PG8_STAGE(PG8_SA(0, 0), a2, voffA);
            PG8_WAIT_V(8); PG8_WAIT_L(0); PG8_BAR; PG8_MMA(1, 0, At, B0); PG8_MMA(1, 1, At, B1); PG8_BAR; PG8_SCHED;
            PG8_LDB(B0, 1, 0); PG8_LDB(B1, 1, 1); PG8_SCHED; PG8_LDA(At, 1, 0); PG8_STAGE(PG8_SA(0, 1), a2 + hstepA, voffA);
            PG8_WAIT_V(8); PG8_WAIT_L(0); PG8_BAR; PG8_MMA(0, 0, At, B0); PG8_MMA(0, 1, At, B1); PG8_BAR; PG8_SCHED;
            PG8_LDA(At, 1, 1); PG8_STAGE(PG8_SB(1, 0), b3, voffB); PG8_STAGE(PG8_SB(1, 1), b3 + hstepB, voffB); PG8_STAGE(PG8_SA(1, 0), a3, voffA);
            PG8_WAIT_V(8); PG8_WAIT_L(0); PG8_BAR; PG8_MMA(1, 0, At, B0); PG8_MMA(1, 1, At, B1); PG8_BAR; PG8_SCHED;
        }
        if (wr == 0) PG8_BAR;
        E(acc, cur, wr, wc, fr, fq);
        if (!has_next) break;
#pragma unroll
        for (int a = 0; a < 2; ++a)
#pragma unroll
            for (int b = 0; b < 2; ++b)
#pragma unroll
                for (int m = 0; m < 4; ++m)
#pragma unroll
                    for (int n = 0; n < 2; ++n) acc[a][b][m][n] = (f32x4){0.f, 0.f, 0.f, 0.f};
        cur = nxt; cA = nA; cB = nB; ++ui;
        if (wr == 1) PG8_BAR;
    }
    PG8_WAIT_V(0);
    PG8_BAR;
#undef PG8_SA
#undef PG8_SB
#undef PG8_STAGE
#undef PG8_LDA
#undef PG8_LDB
#undef PG8_MMA
#undef PG8_WAIT_V
#undef PG8_WAIT_L
#undef PG8_BAR
#undef PG8_SCHED
}
typedef f32x4 Acc[2][2][4][2];

struct EpiSwiglu {
    bf16_t* H; const float* rs;
    __device__ __forceinline__ void operator()(const Acc& acc, const Unit& u, int wr, int wc, int fr, int fq) const {
        const int col0 = u.pn * 128 + wc * 32 + 8 * fq;
        float tpre[2][4];
#pragma unroll
        for (int ai = 0; ai < 2; ++ai)
#pragma unroll
            for (int m = 0; m < 4; ++m) tpre[ai][m] = rs[u.pm * BM + ai * HALF + wr * 64 + m * 16 + fr];
        asm volatile("" ::: "memory");
#pragma unroll
        for (int ai = 0; ai < 2; ++ai)
#pragma unroll
            for (int m = 0; m < 4; ++m) {
                const int r = u.pm * BM + ai * HALF + wr * 64 + m * 16 + fr; const float t = rstd_of(tpre[ai][m], 1.f / 1024.f);
                const float tl = -t * 1.4426950408889634f, t2 = t * t;
                f32x4 o0, o1;
#pragma unroll
                for (int n = 0; n < 2; ++n)
#pragma unroll
                    for (int jj = 0; jj < 2; ++jj) {
                        const f32x2_t g = {acc[ai][0][m][n][2 * jj], acc[ai][0][m][n][2 * jj + 1]}, uu = {acc[ai][1][m][n][2 * jj], acc[ai][1][m][n][2 * jj + 1]};
                        const f32x2_t z = g * tl; f32x2_t e; e.x = __builtin_amdgcn_exp2f(z.x); e.y = __builtin_amdgcn_exp2f(z.y);
                        const f32x2_t d = e + 1.0f; f32x2_t rr; rr.x = __builtin_amdgcn_rcpf(d.x); rr.y = __builtin_amdgcn_rcpf(d.y);
                        const f32x2_t o = (g * uu) * (rr * t2);
                        if (n == 0) { o0[2 * jj] = o.x; o0[2 * jj + 1] = o.y; } else { o1[2 * jj] = o.x; o1[2 * jj + 1] = o.y; }
                    }
                *(u32x4*)(H + (size_t)r * FF + col0) = pack8(o0, o1);
            }
    }
};
template <bool PLE> struct EpiResid {
    const float* hsrc; float* h; bf16_t* hb; float* rs_out; float alpha; const bf16_t* tmp; const float* rs_in; int dry;
    __device__ __forceinline__ void operator()(const Acc& acc, const Unit& u, int wr, int wc, int fr, int fq) const {
        constexpr int MB = PLE ? 2 : 4;
#pragma unroll
        for (int ai = 0; ai < 2; ++ai)
#pragma unroll
        for (int mb = 0; mb < 4; mb += MB) {
            f32x4 pa[MB][2], pb[MB][2]; u32x4 pt[MB][2]; float tt[MB];
#pragma unroll
            for (int mm = 0; mm < MB; ++mm) {
                const int m = mb + mm; const int r = u.pm * BM + ai * HALF + wr * 64 + m * 16 + fr;
                tt[mm] = PLE ? rs_in[r] : 0.f;
#pragma unroll
                for (int bj = 0; bj < 2; ++bj) {
                    const int c0 = u.pn * BM + wc * 64 + bj * 32 + 8 * fq; const float* hs = hsrc + (size_t)r * DM + c0;
                    pa[mm][bj] = *(const f32x4*)hs; pb[mm][bj] = *(const f32x4*)(hs + 4);
                    if (PLE) pt[mm][bj] = *(const u32x4*)(tmp + (size_t)r * DM + c0);
                }
            }
#pragma unroll
            for (int mm = 0; mm < MB; ++mm) {
                const int m = mb + mm; const int r = u.pm * BM + ai * HALF + wr * 64 + m * 16 + fr; float ss = 0.f;
                const float t = PLE ? rstd_of(tt[mm], 1.f / 1024.f) : 1.f; const float tl = -t * 1.4426950408889634f; (void)tl;
#pragma unroll
                for (int bj = 0; bj < 2; ++bj) {
                    const int c0 = u.pn * BM + wc * 64 + bj * 32 + 8 * fq; float* hp = h + (size_t)r * DM + c0;
                    f32x4 a = pa[mm][bj], b = pb[mm][bj];
                    if (PLE) { f32x4 ta, tb; unpack8(pt[mm][bj], ta, tb);
#pragma unroll
                        for (int j = 0; j < 4; ++j) { a[j] += ta[j] * __builtin_amdgcn_rcpf(1.f + __builtin_amdgcn_exp2f(acc[ai][bj][m][0][j] * tl)); b[j] += tb[j] * __builtin_amdgcn_rcpf(1.f + __builtin_amdgcn_exp2f(acc[ai][bj][m][1][j] * tl)); } }
                    else { a += acc[ai][bj][m][0] * alpha; b += acc[ai][bj][m][1] * alpha; }
                    if (!dry || a[0] == 1234.56789f) { *(f32x4*)hp = a; *(f32x4*)(hp + 4) = b;
                    *(u32x4*)(hb + (size_t)r * DM + c0) = pack8(a, b); }
                    ss += (a[0] * a[0] + a[1] * a[1]) + (a[2] * a[2] + a[3] * a[3]) + (b[0] * b[0] + b[1] * b[1]) + (b[2] * b[2] + b[3] * b[3]);
                }
                ss += __shfl_xor(ss, 16); ss += __shfl_xor(ss, 32);
                if (fq == 0 && (!dry || ss == 1234.56789f)) unsafeAtomicAdd(rs_out + r, ss);
            }
            asm volatile("" ::: "memory");
        }
    }
};
struct EpiInproj {
    bf16_t* P; const float* rs; float* rs_q; float* rs_kv; const float* rope; const float* lbt; int dry;
    __device__ __forceinline__ void operator()(const Acc& acc, const Unit& u, int wr, int wc, int fr, int fq) const {
        float tpre[2][4];
#pragma unroll
        for (int ai = 0; ai < 2; ++ai)
#pragma unroll
            for (int m = 0; m < 4; ++m) tpre[ai][m] = rs[u.pm * BM + ai * HALF + wr * 64 + m * 16 + fr];
        asm volatile("" ::: "memory");
#pragma unroll
        for (int ai = 0; ai < 2; ++ai)
#pragma unroll
            for (int m = 0; m < 4; ++m) {
                const int r = u.pm * BM + ai * HALF + wr * 64 + m * 16 + fr; const float t = rstd_of(tpre[ai][m], 1.f / 1024.f);
#pragma unroll
                for (int bj = 0; bj < 2; ++bj) {
                    const int G32 = 8 * u.pn + 2 * wc + bj; const int c0 = 32 * G32 + 8 * fq;
                    f32x4 v0 = acc[ai][bj][m][0] * t, v1 = acc[ai][bj][m][1] * t;
                    if (G32 < 20) {
                        float ss = (v0[0] * v0[0] + v0[1] * v0[1]) + (v0[2] * v0[2] + v0[3] * v0[3]) + (v1[0] * v1[0] + v1[1] * v1[1]) + (v1[2] * v1[2] + v1[3] * v1[3]);
                        ss += __shfl_xor(ss, 16); ss += __shfl_xor(ss, 32);
                        if (fq == 0 && (!dry || ss == 1234.56789f)) unsafeAtomicAdd((G32 < 12 ? rs_q : rs_kv) + r, ss);
                    }
                    if (G32 >= 52 && G32 < 68) {
#pragma unroll
                        for (int j = 0; j < 4; ++j) { v0[j] = siluf_(v0[j]); v1[j] = siluf_(v1[j]); }
                    } else if (G32 >= 68 && G32 < 84) {
                        const f32x4 l0 = *(const f32x4*)(lbt + 32 * (G32 - 68) + 8 * fq), l1 = *(const f32x4*)(lbt + 32 * (G32 - 68) + 8 * fq + 4);
#pragma unroll
                        for (int j = 0; j < 4; ++j) {
                            { const float x = v0[j], e = __expf(-fabsf(x)), d = __builtin_amdgcn_rcpf(1.f + e), sp = x >= 0.f ? d : e * d; v0[j] = __builtin_amdgcn_logf(fminf(fmaxf(l0[j], 1e-30f) + (1.f - l0[j]) * sp, 1.f)); }
                            { const float x = v1[j], e = __expf(-fabsf(x)), d = __builtin_amdgcn_rcpf(1.f + e), sp = x >= 0.f ? d : e * d; v1[j] = __builtin_amdgcn_logf(fminf(fmaxf(l1[j], 1e-30f) + (1.f - l1[j]) * sp, 1.f)); }
                        }
                    }
                    if (G32 > 116) continue;
                    if (G32 == 116) { rope8(v0, v1, rope + (size_t)r * 16, rope + (size_t)T * 16 + (size_t)r * 16, fq); }
                    if (!dry || v0[0] == 1234.56789f) *(u32x4*)(P + (size_t)r * PW + c0) = pack8(v0, v1);
                }
            }
    }
};
struct EpiQup {
    bf16_t* Q; const float* rs_q; const float* rope;
    __device__ __forceinline__ void operator()(const Acc& acc, const Unit& u, int wr, int wc, int fr, int fq) const {
        float tpre[2][4];
#pragma unroll
        for (int ai = 0; ai < 2; ++ai)
#pragma unroll
            for (int m = 0; m < 4; ++m) tpre[ai][m] = rs_q[u.pm * BM + ai * HALF + wr * 64 + m * 16 + fr];
        asm volatile("" ::: "memory");
#pragma unroll
        for (int ai = 0; ai < 2; ++ai)
#pragma unroll
            for (int m = 0; m < 4; ++m) {
                const int r = u.pm * BM + ai * HALF + wr * 64 + m * 16 + fr; const float t = rstd_of(tpre[ai][m], 1.f / 384.f);
#pragma unroll
                for (int bj = 0; bj < 2; ++bj) {
                    const int c0 = u.pn * BM + wc * 64 + bj * 32 + 8 * fq;
                    f32x4 v0 = acc[ai][bj][m][0] * t, v1 = acc[ai][bj][m][1] * t;
                    if (u.pn == 2) rope8(v0, v1, rope + (size_t)r * 16, rope + (size_t)T * 16 + (size_t)r * 16, fq);
                    *(u32x4*)(Q + (size_t)r * 768 + c0) = pack8(v0, v1);
                }
            }
    }
};
struct EpiStore {
    bf16_t* O; int ldc; const float* rs; float invn; int sig;
    __device__ __forceinline__ void operator()(const Acc& acc, const Unit& u, int wr, int wc, int fr, int fq) const {
        float tpre[2][4];
#pragma unroll
        for (int ai = 0; ai < 2; ++ai)
#pragma unroll
            for (int m = 0; m < 4; ++m) tpre[ai][m] = rs ? rs[u.pm * BM + ai * HALF + wr * 64 + m * 16 + fr] : 0.f;
        asm volatile("" ::: "memory");
#pragma unroll
        for (int ai = 0; ai < 2; ++ai)
#pragma unroll
            for (int m = 0; m < 4; ++m) {
                const int r = u.pm * BM + ai * HALF + wr * 64 + m * 16 + fr; const float t = rs ? rstd_of(tpre[ai][m], invn) : 1.f;
#pragma unroll
                for (int bj = 0; bj < 2; ++bj) {
                    const int c0 = u.pn * BM + wc * 64 + bj * 32 + 8 * fq;
                    f32x4 v0 = acc[ai][bj][m][0] * t, v1 = acc[ai][bj][m][1] * t;
                    if (sig) { const float tl = -t * 1.4426950408889634f; const f32x4 z0 = acc[ai][bj][m][0] * tl, z1 = acc[ai][bj][m][1] * tl;
#pragma unroll
                        for (int j = 0; j < 4; ++j) { v0[j] = __builtin_amdgcn_rcpf(1.f + __builtin_amdgcn_exp2f(z0[j])); v1[j] = __builtin_amdgcn_rcpf(1.f + __builtin_amdgcn_exp2f(z1[j])); } }
                    *(u32x4*)(O + (size_t)r * ldc + c0) = pack8(v0, v1);
                }
            }
    }
};
struct EpiStoreCol {
    bf16_t* O; int ldc; const float* rs; float invn;
    __device__ __forceinline__ void operator()(const Acc& acc, const Unit& u, int wr, int wc, int fr, int fq) const {
#pragma unroll
        for (int bj = 0; bj < 2; ++bj) {
            const int c0 = u.pn * BM + wc * 64 + bj * 32 + 8 * fq;
            f32x4 t0 = *(const f32x4*)(rs + c0), t1 = *(const f32x4*)(rs + c0 + 4);
#pragma unroll
            for (int j = 0; j < 4; ++j) { t0[j] = rstd_of(t0[j], invn); t1[j] = rstd_of(t1[j], invn); }
#pragma unroll
            for (int ai = 0; ai < 2; ++ai)
#pragma unroll
                for (int m = 0; m < 4; ++m) {
                    const int r = u.pm * BM + ai * HALF + wr * 64 + m * 16 + fr;
                    *(u32x4*)(O + (size_t)r * ldc + c0) = pack8(acc[ai][bj][m][0] * t0, acc[ai][bj][m][1] * t1);
                }
        }
    }
};
struct EpiBranch {
    bf16_t* Mg; const bf16_t* G; int ldg; int first;
    __device__ __forceinline__ void operator()(const Acc& acc, const Unit& u, int wr, int wc, int fr, int fq) const {
#pragma unroll
        for (int ai = 0; ai < 2; ++ai) {
            u32x4 pg[4][2], pm_[4][2];
#pragma unroll
            for (int m = 0; m < 4; ++m) {
                const int r = u.pm * BM + ai * HALF + wr * 64 + m * 16 + fr;
#pragma unroll
                for (int bj = 0; bj < 2; ++bj) {
                    const int c0 = u.pn * BM + wc * 64 + bj * 32 + 8 * fq;
                    pg[m][bj] = *(const u32x4*)(G + (size_t)r * ldg + c0);
                    pm_[m][bj] = first ? (u32x4){0u, 0u, 0u, 0u} : *(const u32x4*)(Mg + (size_t)r * DM + c0);
                }
            }
#pragma unroll
            for (int m = 0; m < 4; ++m) {
                const int r = u.pm * BM + ai * HALF + wr * 64 + m * 16 + fr;
#pragma unroll
                for (int bj = 0; bj < 2; ++bj) {
                    const int c0 = u.pn * BM + wc * 64 + bj * 32 + 8 * fq;
                    f32x4 g0, g1, m0, m1; unpack8(pg[m][bj], g0, g1); unpack8(pm_[m][bj], m0, m1);
                    m0 += g0 * acc[ai][bj][m][0]; m1 += g1 * acc[ai][bj][m][1];
                    *(u32x4*)(Mg + (size_t)r * DM + c0) = pack8(m0, m1);
                }
            }
            asm volatile("" ::: "memory");
        }
    }
};
}

template <class Epi>
__device__ __forceinline__ void run_gemm(LAS unsigned char* lds, const bf16_t* A, int lda, const bf16_t* Bt, int ldb, int M, int N, int K, const Epi& E) {
    pg8::Gemm g{A, Bt, lda, ldb, M, N, K}; pg8::StaticOrder S; S.init(M, N, (int)gridDim.x, (int)blockIdx.x);
    pg8::gemm_phase<Epi>(lds, g, S, E);
}

enum { MAP_ID = 0, MAP_SWIGLU, MAP_INMAIN, MAP_UQ, MAP_UK, MAP_UV };
__device__ __forceinline__ int src_col(int map, int off, int n) {
    switch (map) {
        case MAP_ID: return off + n;
        case MAP_SWIGLU: { const int pn = n >> 8, c = n & 255, wc = c >> 6, bj = (c >> 5) & 1, i = c & 31; return bj * FF + 128 * pn + 32 * wc + i; }
        case MAP_INMAIN: {
            if (n < 640) return n;
            if (n < 1664) return 672 + (n - 640);
            if (n < 3712) return 2208 + (n - 1664);
            if (n < 3744) { const int pp = n - 3712, a = pp >> 3, nn = (pp >> 2) & 1, j = pp & 3; return 640 + 16 * nn + 4 * a + j; }
            return -1; }
        case MAP_UQ: {
            if (n < 512) { const int hh = n >> 6, d = n & 63; return 96 * hh + d; }
            const int p = n - 512, hh = p >> 5, pp = p & 31, a = pp >> 3, nn = (pp >> 2) & 1, j = pp & 3; return 96 * hh + 64 + 16 * nn + 4 * a + j; }
        case MAP_UK: { const int hh = n >> 6, d = n & 63; return 128 * hh + d; }
        default: { const int hh = n >> 6, d = n & 63; return 128 * hh + 64 + d; }
    }
}
struct Job { const float* W; const float* gain; bf16_t* dst; int K, Nsrc, Nd, map, off; };
__device__ __forceinline__ Job get_job(int layer, int j) {
    KPtr P = kparams();
    Job J; bf16_t* wb = (bf16_t*)(P->ws + WS_W); bf16_t* wp = (bf16_t*)(P->ws + WS_WPLE + (size_t)layer * WPLE_STRIDE);
    J.gain = nullptr; J.map = MAP_ID; J.off = 0;
    switch (j) {
        case 0: J.W = P->ffn_a_w_in + (size_t)layer * 1024 * 5632; J.gain = P->ffn_a_norm + layer * 1024; J.dst = wb + WO_A_IN; J.K = 1024; J.Nsrc = 5632; J.Nd = 5632; J.map = MAP_SWIGLU; break;
        case 1: J.W = P->ffn_a_w_out + (size_t)layer * 2816 * 1024; J.dst = wb + WO_A_OUT; J.K = 2816; J.Nsrc = 1024; J.Nd = 1024; break;
        case 2: J.W = P->w_in + (size_t)layer * 1024 * 7328; J.gain = P->mix_norm + layer * 1024; J.dst = wb + WO_IN; J.K = 1024; J.Nsrc = 7328; J.Nd = 3840; J.map = MAP_INMAIN; break;
        case 3: J.W = P->w_in + (size_t)layer * 1024 * 7328; J.gain = P->mix_norm + layer * 1024; J.dst = wb + WO_SBV; J.K = 1024; J.Nsrc = 7328; J.Nd = 512; J.off = 1696; break;
        case 4: J.W = P->w_in + (size_t)layer * 1024 * 7328; J.gain = P->mix_norm + layer * 1024; J.dst = wb + WO_GATE; J.K = 1024; J.Nsrc = 7328; J.Nd = 3072; J.off = 4256; break;
        case 5: J.W = P->mla_w_uq + (size_t)layer * 384 * 768; J.gain = P->mla_q_norm + layer * 384; J.dst = wb + WO_UQ; J.K = 384; J.Nsrc = 768; J.Nd = 768; J.map = MAP_UQ; break;
        case 6: J.W = P->mla_w_ukv + (size_t)layer * 256 * 1024; J.gain = P->mla_kv_norm + layer * 256; J.dst = wb + WO_UK; J.K = 256; J.Nsrc = 1024; J.Nd = 512; J.map = MAP_UK; break;
        case 7: J.W = P->mla_w_ukv + (size_t)layer * 256 * 1024; J.gain = P->mla_kv_norm + layer * 256; J.dst = wb + WO_UV; J.K = 256; J.Nsrc = 1024; J.Nd = 512; J.map = MAP_UV; break;
        case 8: J.W = P->w_br_mla + (size_t)layer * 512 * 1024; J.dst = wb + WO_BR; J.K = 512; J.Nsrc = 1024; J.Nd = 1024; break;
        case 9: J.W = P->w_br_sb + (size_t)layer * 512 * 1024; J.dst = wb + WO_BR + (size_t)1024 * 512; J.K = 512; J.Nsrc = 1024; J.Nd = 1024; break;
        case 10: J.W = P->w_br_hgrn + (size_t)layer * 512 * 1024; J.dst = wb + WO_BR + (size_t)2 * 1024 * 512; J.K = 512; J.Nsrc = 1024; J.Nd = 1024; break;
        case 11: J.W = P->w_out + (size_t)layer * 1024 * 1024; J.dst = wb + WO_OUT; J.K = 1024; J.Nsrc = 1024; J.Nd = 1024; break;
        case 12: J.W = P->ffn_b_w_in + (size_t)layer * 1024 * 5632; J.gain = P->ffn_b_norm + layer * 1024; J.dst = wb + WO_B_IN; J.K = 1024; J.Nsrc = 5632; J.Nd = 5632; J.map = MAP_SWIGLU; break;
        case 13: J.W = P->ffn_b_w_out + (size_t)layer * 2816 * 1024; J.dst = wb + WO_B_OUT; J.K = 2816; J.Nsrc = 1024; J.Nd = 1024; break;
        case 14: J.W = P->w_ple_gate + (size_t)layer * 1024 * 1024; J.gain = P->ple_norm + layer * 1024; J.dst = wp; J.K = 1024; J.Nsrc = 1024; J.Nd = 1024; break;
        default: J.W = P->w_ple_proj + (size_t)layer * 256 * 1024; J.dst = wp + (size_t)1024 * 1024; J.K = 256; J.Nsrc = 1024; J.Nd = 1024; break;
    }
    return J;
}
__device__ __forceinline__ void convert_item(const Job& J, LAS float* scr, int item, int lane) {
    const int nblk = J.Nd / 32, kb = item / nblk, nb = item % nblk, k0 = 64 * kb, n0 = 32 * nb;
    const int sc = src_col(J.map, J.off, n0 + (lane & 31));
    const float* src = J.W + (size_t)(k0 + (lane >> 5)) * J.Nsrc + (sc >= 0 ? sc : 0);
    float vals[32];
#pragma unroll
    for (int i = 0; i < 32; ++i) vals[i] = src[(size_t)(2 * i) * J.Nsrc];
    const int c = lane & 7;
    f32x4 g0 = {1.f, 1.f, 1.f, 1.f}, g1 = g0;
    if (J.gain) { g0 = *(const f32x4*)(J.gain + k0 + 8 * c); g1 = *(const f32x4*)(J.gain + k0 + 8 * c + 4); }
#pragma unroll
    for (int i = 0; i < 32; ++i) scr[(2 * i + (lane >> 5)) * 33 + (lane & 31)] = sc >= 0 ? vals[i] : 0.f;
    asm volatile("s_waitcnt lgkmcnt(0)" ::: "memory");
#pragma unroll
    for (int j = 0; j < 4; ++j) { const int n = (lane >> 3) + 8 * j; const LAS float* s = scr + (8 * c) * 33 + n;
        u32x4 o; o.x = cvtpk(s[0 * 33] * g0[0], s[1 * 33] * g0[1]); o.y = cvtpk(s[2 * 33] * g0[2], s[3 * 33] * g0[3]); o.z = cvtpk(s[4 * 33] * g1[0], s[5 * 33] * g1[1]); o.w = cvtpk(s[6 * 33] * g1[2], s[7 * 33] * g1[3]);
        *(u32x4*)(J.dst + (size_t)(n0 + n) * J.K + k0 + 8 * c) = o; }
    asm volatile("s_waitcnt lgkmcnt(0)" ::: "memory");
}
__device__ __forceinline__ void convert_weights(LAS unsigned char* lds, int layer, int j0, int j1) {
    const int tid = otid(); const int lane = tid & 63, wid = tid >> 6;
    LAS float* scr = (LAS float*)(lds + wid * 8704);
    const int gw = blockIdx.x * NWAVES + wid, NGW = gridDim.x * NWAVES;
    for (int j = j0; j < j1; ++j) {
        const Job J = get_job(layer, j);
        const int nitems = (J.K / 64) * (J.Nd / 32);
        for (int it = gw; it < nitems; it += NGW) convert_item(J, scr, it, lane);
    }
}

constexpr int MLA_KSTR = 208, MLA_VSTR = 144, MLA_KB = 64 * MLA_KSTR, MLA_VB = 64 * MLA_VSTR;
template <bool DRY> __device__ __forceinline__ void mla_unit(LAS unsigned char* lds, int b, int h, int qb, const bf16_t* Q, const bf16_t* Kn, const bf16_t* Pm, const bf16_t* VT, bf16_t* Y) {
    const int tid = otid(), lane = tid & 63, r32 = lane & 31, hi = lane >> 5; const int wid = __builtin_amdgcn_readfirstlane(tid >> 6);
    const int NT = 4 * qb + 4, tmax = 4 * qb + (wid >> 1);
    const size_t tok0 = (size_t)b * SEQ;
    const size_t qtok = tok0 + qb * 256 + wid * 32 + r32;
    const bf16_t* qrow = Q + qtok * 768;
    bf16x8 qf[6];
#pragma unroll
    for (int s = 0; s < 4; ++s) qf[s] = *(const bf16x8*)(qrow + h * 64 + 16 * s + 8 * hi);
#pragma unroll
    for (int s = 0; s < 2; ++s) qf[4 + s] = *(const bf16x8*)(qrow + 512 + h * 32 + 16 * s + 8 * hi);
    const int ka_row = tid >> 3, ka_c = tid & 7, kb_row = (tid & 255) >> 2, kb_c = tid & 3;
    const bf16_t* ka_src = Kn + (tok0 + ka_row) * 512 + h * 64 + ka_c * 8;
    const bf16_t* kb_src = Pm + (tok0 + kb_row) * PW + PC_KR + kb_c * 8;
    const bf16_t* va_src = VT + (size_t)(h * 64 + ka_row) * T + tok0 + ka_c * 8;
    const int ka_dst = ka_row * MLA_KSTR + ka_c * 16, kb_dst = kb_row * MLA_KSTR + 128 + kb_c * 16, va_dst = ka_row * MLA_VSTR + ka_c * 16;
    u32x4 ra = *(const u32x4*)ka_src, rb = *(const u32x4*)kb_src, rv = *(const u32x4*)va_src;
    float m_run = -1e30f, l_run = 0.f; f32x16 o0 = {}, o1 = {};
    const float C = 0.10206207261596577f * 1.4426950408889634f;
    for (int t = 0; t < NT; ++t) {
        LAS unsigned char* kbuf = lds + (t & 1) * MLA_KB; LAS unsigned char* vbuf = lds + 2 * MLA_KB + (t & 1) * MLA_VB;
        *(LAS u32x4*)(kbuf + ka_dst) = ra; if (tid < 256) *(LAS u32x4*)(kbuf + kb_dst) = rb; *(LAS u32x4*)(vbuf + va_dst) = rv;
        LDS_BARRIER();
        if (t + 1 < NT) { ra = *(const u32x4*)(ka_src + (size_t)(t + 1) * 64 * 512); rb = *(const u32x4*)(kb_src + (size_t)(t + 1) * 64 * PW); rv = *(const u32x4*)(va_src + (t + 1) * 64); }
        if (t <= tmax) {
            f32x16 p0 = {}, p1 = {};
#pragma unroll
            for (int s = 0; s < 6; ++s) {
                const bf16x8 a0 = *(const LAS bf16x8*)(kbuf + r32 * MLA_KSTR + s * 32 + hi * 16);
                const bf16x8 a1 = *(const LAS bf16x8*)(kbuf + (32 + r32) * MLA_KSTR + s * 32 + hi * 16);
                p0 = __builtin_amdgcn_mfma_f32_32x32x16_bf16(a0, qf[s], p0, 0, 0, 0);
                p1 = __builtin_amdgcn_mfma_f32_32x32x16_bf16(a1, qf[s], p1, 0, 0, 0);
            }
            float mx = fmaxf(p0[0], p1[0]);
#pragma unroll
            for (int r = 1; r < 16; ++r) mx = fmaxf(mx, fmaxf(p0[r], p1[r]));
            mx = fmaxf(mx, __shfl_xor(mx, 32));
            const float m_new = fmaxf(m_run, mx * C); const float alpha = __builtin_amdgcn_exp2f(m_run - m_new); m_run = m_new;
            float ls = 0.f;
#pragma unroll
            for (int r = 0; r < 16; ++r) { p0[r] = __builtin_amdgcn_exp2f(p0[r] * C - m_new); p1[r] = __builtin_amdgcn_exp2f(p1[r] * C - m_new); ls += p0[r] + p1[r]; }
            l_run = l_run * alpha + ls;
#pragma unroll
            for (int r = 0; r < 16; ++r) { o0[r] *= alpha; o1[r] *= alpha; }
            u32x4 pw[4];
#pragma unroll
            for (int s = 0; s < 2; ++s) {
                pw[s] = (u32x4){cvtpk(p0[8 * s + 0], p0[8 * s + 1]), cvtpk(p0[8 * s + 2], p0[8 * s + 3]), cvtpk(p0[8 * s + 4], p0[8 * s + 5]), cvtpk(p0[8 * s + 6], p0[8 * s + 7])};
                pw[2 + s] = (u32x4){cvtpk(p1[8 * s + 0], p1[8 * s + 1]), cvtpk(p1[8 * s + 2], p1[8 * s + 3]), cvtpk(p1[8 * s + 4], p1[8 * s + 5]), cvtpk(p1[8 * s + 6], p1[8 * s + 7])};
            }
#pragma unroll
            for (int ks = 0; ks < 4; ++ks) {
                const bf16x8 pf = __builtin_bit_cast(bf16x8, pw[ks]);
                const s16x4 l0 = *(const LAS s16x4*)(vbuf + r32 * MLA_VSTR + (16 * ks + 4 * hi) * 2);
                const s16x4 h0 = *(const LAS s16x4*)(vbuf + r32 * MLA_VSTR + (16 * ks + 8 + 4 * hi) * 2);
                const s16x4 l1 = *(const LAS s16x4*)(vbuf + (32 + r32) * MLA_VSTR + (16 * ks + 4 * hi) * 2);
                const s16x4 h1 = *(const LAS s16x4*)(vbuf + (32 + r32) * MLA_VSTR + (16 * ks + 8 + 4 * hi) * 2);
                const bf16x8 v0 = (bf16x8){l0[0], l0[1], l0[2], l0[3], h0[0], h0[1], h0[2], h0[3]};
                const bf16x8 v1 = (bf16x8){l1[0], l1[1], l1[2], l1[3], h1[0], h1[1], h1[2], h1[3]};
                o0 = __builtin_amdgcn_mfma_f32_32x32x16_bf16(v0, pf, o0, 0, 0, 0);
                o1 = __builtin_amdgcn_mfma_f32_32x32x16_bf16(v1, pf, o1, 0, 0, 0);
            }
        }
    }
    const float l = l_run + __shfl_xor(l_run, 32); const float inv = 1.f / l;
    bf16_t* yrow = Y + qtok * 768 + h * 64;
#pragma unroll
    for (int g = 0; g < 4; ++g) {
        u32x2 w0, w1;
        w0.x = cvtpk(o0[4 * g] * inv, o0[4 * g + 1] * inv); w0.y = cvtpk(o0[4 * g + 2] * inv, o0[4 * g + 3] * inv);
        w1.x = cvtpk(o1[4 * g] * inv, o1[4 * g + 1] * inv); w1.y = cvtpk(o1[4 * g + 2] * inv, o1[4 * g + 3] * inv);
        if (!DRY || l == 1234.56789f) { *(u32x2*)(yrow + 8 * g + 4 * hi) = w0; *(u32x2*)(yrow + 32 + 8 * g + 4 * hi) = w1; }
    }
}

struct SbFrags { bf16x8 kf[4]; s16x4 v[8]; };
__device__ __forceinline__ void sb_load(SbFrags& F, const bf16_t* Pm, const bf16_t* VT, size_t tok0, int kv0, int h, int r32, int hi) {
    const bf16_t* krow = Pm + (tok0 + kv0 + r32) * PW + PC_SBK + h * 64;
#pragma unroll
    for (int s = 0; s < 4; ++s) F.kf[s] = *(const bf16x8*)(krow + 16 * s + 8 * hi);
#pragma unroll
    for (int s = 0; s < 2; ++s) {
        const bf16_t* v0p = VT + (size_t)(h * 64 + r32) * T + tok0 + kv0 + 16 * s + 4 * hi; const bf16_t* v1p = v0p + (size_t)32 * T;
        F.v[4 * s + 0] = *(const s16x4*)v0p; F.v[4 * s + 1] = *(const s16x4*)(v0p + 8); F.v[4 * s + 2] = *(const s16x4*)v1p; F.v[4 * s + 3] = *(const s16x4*)(v1p + 8);
    }
}
template <bool DRY> __device__ __forceinline__ void sb_unit(int b, int h, int qi, bf16_t* Pm, const bf16_t* VT) {
    const int lane = otid() & 63, r32 = lane & 31, hi = lane >> 5;
    const size_t tok0 = (size_t)b * SEQ; const int q0 = qi * 32;
    bf16_t* qrow = Pm + (tok0 + q0 + r32) * PW + PC_SBQ + h * 64;
    bf16x8 qf[4];
#pragma unroll
    for (int s = 0; s < 4; ++s) qf[s] = *(const bf16x8*)(qrow + 16 * s + 8 * hi);
    float R = 0.f; f32x16 o0 = {}, o1 = {};
    SbFrags cur, nxt;
    sb_load(cur, Pm, VT, tok0, qi * 32, h, r32, hi);
#pragma unroll 1
    for (int kt = qi; kt >= 0; --kt) {
        sb_load(nxt, Pm, VT, tok0, (kt > 0 ? kt - 1 : 0) * 32, h, r32, hi);
        f32x16 p = {};
#pragma unroll
        for (int s = 0; s < 4; ++s) p = __builtin_amdgcn_mfma_f32_32x32x16_bf16(cur.kf[s], qf[s], p, 0, 0, 0);
        const bool diag = (kt == qi);
        float lk[16], inner[16], Tg[4], TP[4], pre[4];
#pragma unroll
        for (int r = 0; r < 16; ++r) {
            const float z = p[r] * 0.125f; p[r] = z;
            const float e = __expf(-fabsf(z)); const float sp = fmaxf(z, 0.f) + __logf(1.f + e);
            const bool valid = !diag || (crow(r, hi) < r32);
            lk[r] = valid ? -sp : 0.f;
        }
#pragma unroll
        for (int g = 0; g < 4; ++g) {
            const float s3 = lk[4 * g + 3], s2 = s3 + lk[4 * g + 2], s1 = s2 + lk[4 * g + 1];
            inner[4 * g + 3] = 0.f; inner[4 * g + 2] = s3; inner[4 * g + 1] = s2; inner[4 * g] = s1; Tg[g] = s1 + lk[4 * g];
            TP[g] = __shfl_xor(Tg[g], 32);
        }
        float run = 0.f;
#pragma unroll
        for (int g = 3; g >= 0; --g) { pre[g] = run + (hi == 0 ? TP[g] : 0.f); run += Tg[g] + TP[g]; }
#pragma unroll
        for (int r = 0; r < 16; ++r) {
            const bool valid = !diag || (crow(r, hi) < r32);
            const float ex = fminf(p[r] + lk[r] + R + pre[r >> 2] + inner[r], 0.f);
            p[r] = valid ? __expf(ex) : 0.f;
        }
        R += run;
#pragma unroll
        for (int s = 0; s < 2; ++s) {
            const u32x4 pw = (u32x4){cvtpk(p[8 * s + 0], p[8 * s + 1]), cvtpk(p[8 * s + 2], p[8 * s + 3]), cvtpk(p[8 * s + 4], p[8 * s + 5]), cvtpk(p[8 * s + 6], p[8 * s + 7])};
            const bf16x8 pf = __builtin_bit_cast(bf16x8, pw);
            const s16x4 l0 = cur.v[4 * s], h0 = cur.v[4 * s + 1], l1 = cur.v[4 * s + 2], h1 = cur.v[4 * s + 3];
            const bf16x8 v0 = (bf16x8){l0[0], l0[1], l0[2], l0[3], h0[0], h0[1], h0[2], h0[3]};
            const bf16x8 v1 = (bf16x8){l1[0], l1[1], l1[2], l1[3], h1[0], h1[1], h1[2], h1[3]};
            o0 = __builtin_amdgcn_mfma_f32_32x32x16_bf16(v0, pf, o0, 0, 0, 0);
            o1 = __builtin_amdgcn_mfma_f32_32x32x16_bf16(v1, pf, o1, 0, 0, 0);
        }
        if (__all(R < -104.f)) break;
        cur = nxt;
    }
#pragma unroll
    for (int g = 0; g < 4; ++g) {
        u32x2 w0, w1;
        w0.x = cvtpk(o0[4 * g], o0[4 * g + 1]); w0.y = cvtpk(o0[4 * g + 2], o0[4 * g + 3]);
        w1.x = cvtpk(o1[4 * g], o1[4 * g + 1]); w1.y = cvtpk(o1[4 * g + 2], o1[4 * g + 3]);
        if (!DRY || R == 1234.56789f) { *(u32x2*)(qrow + 8 * g + 4 * hi) = w0; *(u32x2*)(qrow + 32 + 8 * g + 4 * hi) = w1; }
    }
}

namespace hg {
constexpr int STR = 272, OFF_QF = 0, OFF_KF = 16 * STR, OFF_KFT = 2 * 16 * STR, OFF_VT = OFF_KFT + 128 * 32, OFF_D = OFF_VT + 32 * 32, BUFB = OFF_D + 512;
constexpr int OFF_S = 2 * BUFB, SB = 32 * STR, OFF_O = OFF_S + 2 * SB, TOTAL = OFF_O + 8 * 16 * 64;
struct Raw { unsigned q[4], f[4], v[4]; };
__device__ __forceinline__ void load_raw(Raw& R, const bf16_t* qsrc, const bf16_t* fsrc, const bf16_t* vsrc, int step, bool isv) {
    const size_t o = (size_t)step * 16 * PW;
#pragma unroll
    for (int i = 0; i < 4; ++i) { R.q[i] = *(const unsigned*)(qsrc + o + (size_t)i * PW); R.f[i] = *(const unsigned*)(fsrc + o + (size_t)i * PW); R.v[i] = *(const unsigned*)(vsrc + o + (size_t)i * PW); }
}
__device__ __forceinline__ void prep(const Raw& Rin, LAS unsigned char* buf, int lane, int kch, int tq, bool isv, int vv, int vtq) {
    Raw R = Rin; const bool kodd = kch & 1, vodd = vv & 1;
#pragma unroll
    for (int i = 0; i < 4; ++i) { asm volatile("" : "+v"(R.q[i])); asm volatile("" : "+v"(R.f[i])); asm volatile("" : "+v"(R.v[i])); }
    float qv[4], kk[4], c[4]; float run = 0.f;
#pragma unroll
    for (int i = 0; i < 4; ++i) {
        qv[i] = __uint_as_float(kodd ? (R.q[i] & 0xffff0000u) : (R.q[i] << 16));
        const float l2 = __uint_as_float(kodd ? (R.f[i] & 0xffff0000u) : (R.f[i] << 16));
        kk[i] = 1.f - __builtin_amdgcn_exp2f(l2);
        run += l2; c[i] = run;
    }
    const float p1 = __shfl(run, (lane - 16) & 63), p2 = __shfl(run, (lane - 32) & 63), p3 = __shfl(run, (lane - 48) & 63);
    const float off = (tq >= 1 ? p1 : 0.f) + (tq >= 2 ? p2 : 0.f) + (tq >= 3 ? p3 : 0.f);
    const float btot = __shfl(off + run, 48 + (lane & 15));
    unsigned short kf[4];
#pragma unroll
    for (int i = 0; i < 4; ++i) {
        const float bt = off + c[i];
        const float qf = qv[i] * __builtin_amdgcn_exp2f(bt), kfv = kk[i] * __builtin_amdgcn_exp2f(-bt);
        const unsigned pk = cvtpk(qf, kfv);
        *(LAS unsigned short*)(buf + OFF_QF + (4 * tq + i) * STR + kch * 2) = (unsigned short)(pk & 0xffffu);
        kf[i] = (unsigned short)(pk >> 16);
        *(LAS unsigned short*)(buf + OFF_KF + (4 * tq + i) * STR + kch * 2) = kf[i];
    }
    *(LAS u32x2*)(buf + OFF_KFT + kch * 32 + tq * 8) = (u32x2){(unsigned)kf[0] | ((unsigned)kf[1] << 16), (unsigned)kf[2] | ((unsigned)kf[3] << 16)};
    if (tq == 0) *(LAS float*)(buf + OFF_D + kch * 4) = __builtin_amdgcn_exp2f(btot);
    if (isv) { unsigned v0 = vodd ? R.v[0] >> 16 : R.v[0] & 0xffffu, v1 = vodd ? R.v[1] >> 16 : R.v[1] & 0xffffu, v2 = vodd ? R.v[2] >> 16 : R.v[2] & 0xffffu, v3 = vodd ? R.v[3] >> 16 : R.v[3] & 0xffffu;
        *(LAS u32x2*)(buf + OFF_VT + vv * 32 + vtq * 8) = (u32x2){v0 | (v1 << 16), v2 | (v3 << 16)}; }
}
}
template <bool DRY> __device__ __forceinline__ void hgrn_unit(LAS unsigned char* lds, int b, int h, int vs, int layer, bf16_t* Pm, const float* lbraw) {
    using namespace hg;
    const int tid = otid(), lane = tid & 63; const int wid = __builtin_amdgcn_readfirstlane(tid >> 6);
    const size_t tok0 = (size_t)b * SEQ;
    const int kl = lane & 15, tq = lane >> 4, kch = 16 * wid + kl;
    (void)layer; (void)lbraw;
    const bf16_t* qsrc = Pm + (tok0 + 4 * tq) * PW + PC_HQ + h * 128 + (kch & ~1);
    const bf16_t* fsrc = Pm + (tok0 + 4 * tq) * PW + PC_HF + h * 128 + (kch & ~1);
    const bool isv = tid < 128; const int vv = tid & 31, vtq = (tid >> 5) & 3;
    const bf16_t* vsrc = Pm + (tok0 + 4 * vtq) * PW + PC_HI + h * 128 + vs * 32 + (vv & ~1);
    constexpr int NSTEP = SEQ / 16;
    for (int i = tid; i < SB / 4; i += NTHREADS) ((LAS unsigned*)(lds + OFF_S + SB))[i] = 0u;
    Raw ra, rb;
    load_raw(ra, qsrc, fsrc, vsrc, 0, isv);
    prep(ra, lds, lane, kch, tq, isv, vv, vtq);
    load_raw(ra, qsrc, fsrc, vsrc, 1, isv); load_raw(rb, qsrc, fsrc, vsrc, 2, isv);
    f32x16 sacc = {};
    const int c16 = lane & 15, kq = lane >> 4, r32 = lane & 31, hh = lane >> 5;
    __syncthreads();
#define HG_STEP(n, RR) do { \
        LAS unsigned char* cur = lds + (n & 1) * BUFB; LAS unsigned char* nxt = lds + ((n + 1) & 1) * BUFB; \
        if (n + 1 < NSTEP) { prep(RR, nxt, lane, kch, tq, isv, vv, vtq); load_raw(RR, qsrc, fsrc, vsrc, (n + 3 < NSTEP) ? n + 3 : NSTEP - 1, isv); } \
        if (wid < 4) {           \
            const bf16x8 a = *(const LAS bf16x8*)(cur + OFF_KFT + (32 * wid + r32) * 32 + 16 * hh); \
            const bf16x8 bb = *(const LAS bf16x8*)(cur + OFF_VT + r32 * 32 + 16 * hh); \
            sacc = __builtin_amdgcn_mfma_f32_32x32x16_bf16(a, bb, sacc, 0, 0, 0); \
            LAS unsigned char* sdst = lds + OFF_S + (n & 1) * SB + r32 * STR + (32 * wid + 4 * hh) * 2; \
_Pragma("unroll") \
            for (int g = 0; g < 4; ++g) { \
                const f32x4 dv = *(const LAS f32x4*)(cur + OFF_D + (32 * wid + 8 * g + 4 * hh) * 4); \
_Pragma("unroll") \
                for (int i = 0; i < 4; ++i) sacc[4 * g + i] *= dv[i]; \
                *(LAS u32x2*)(sdst + 16 * g) = (u32x2){cvtpk(sacc[4 * g], sacc[4 * g + 1]), cvtpk(sacc[4 * g + 2], sacc[4 * g + 3])}; \
            } \
        } else if (wid < 6) {    \
            const int vt = wid - 4; \
            LAS unsigned char* sprev = lds + OFF_S + ((n + 1) & 1) * SB; \
            bf16x8 qfr[4]; f32x4 at = {0.f, 0.f, 0.f, 0.f}; \
_Pragma("unroll") \
            for (int c = 0; c < 4; ++c) { \
                qfr[c] = *(const LAS bf16x8*)(cur + OFF_QF + c16 * STR + (32 * c + 8 * kq) * 2); \
                const bf16x8 kfr = *(const LAS bf16x8*)(cur + OFF_KF + c16 * STR + (32 * c + 8 * kq) * 2); \
                at = __builtin_amdgcn_mfma_f32_16x16x32_bf16(kfr, qfr[c], at, 0, 0, 0); \
            } \
_Pragma("unroll") \
            for (int r = 0; r < 4; ++r) at[r] = (4 * kq + r <= c16) ? at[r] : 0.f; \
            const u32x4 pw = (u32x4){cvtpk(at[0], at[1]), cvtpk(at[2], at[3]), 0u, 0u}; \
            const u32x2 vlo = *(const LAS u32x2*)(cur + OFF_VT + (16 * vt + c16) * 32 + kq * 8); \
            const u32x4 vw = (u32x4){vlo.x, vlo.y, 0u, 0u}; \
            f32x4 o = {0.f, 0.f, 0.f, 0.f}; \
            o = __builtin_amdgcn_mfma_f32_16x16x32_bf16(__builtin_bit_cast(bf16x8, vw), __builtin_bit_cast(bf16x8, pw), o, 0, 0, 0); \
_Pragma("unroll") \
            for (int c = 0; c < 4; ++c) { \
                const bf16x8 sa = *(const LAS bf16x8*)(sprev + (16 * vt + c16) * STR + (32 * c + 8 * kq) * 2); \
                o = __builtin_amdgcn_mfma_f32_16x16x32_bf16(sa, qfr[c], o, 0, 0, 0); \
            } \
            const u32x2 ow = (u32x2){cvtpk(o[0], o[1]), cvtpk(o[2], o[3])}; \
            *(LAS u32x2*)(lds + OFF_O + (((n) & 7) * 16 + c16) * 64 + (16 * vt + 4 * kq) * 2) = ow; \
        } \
        LDS_BARRIER(); } while (0)
#pragma unroll 1
    for (int g8 = 0; g8 < NSTEP; g8 += 8) {
#pragma unroll 1
        for (int n2 = g8; n2 < g8 + 8; n2 += 2) {
            { const int n = n2; HG_STEP(n, ra); }
            { const int n = n2 + 1; HG_STEP(n, rb); }
        }
        {
            const int row = tid >> 2, chk = tid & 3;
            const u32x4 ov = *(const LAS u32x4*)(lds + OFF_O + row * 64 + chk * 16);
            if (!DRY || ov.x == 0x12345678u) *(u32x4*)(Pm + (tok0 + (size_t)g8 * 16 + row) * PW + PC_HI + h * 128 + vs * 32 + chk * 8) = ov;
            __builtin_amdgcn_s_waitcnt(0x0F70);
            LDS_BARRIER();
        }
    }
#undef HG_STEP
    __syncthreads();
}
__device__ __forceinline__ void hgrn_finish(bf16_t* Pm, const float* normw) {
    const int tid = otid(); const int lane = tid & 63, wid = tid >> 6;
    const int gw = blockIdx.x * NWAVES + wid, NGW = gridDim.x * NWAVES;
    f32x4 w0 = *(const f32x4*)(normw + lane * 8), w1 = *(const f32x4*)(normw + lane * 8 + 4);
    for (int t = gw; t < T; t += NGW) {
        bf16_t* op = Pm + (size_t)t * PW + PC_HI + lane * 8; const bf16_t* gp = Pm + (size_t)t * PW + PC_HG + lane * 8;
        f32x4 a, b, g0, g1; unpack8(*(const u32x4*)op, a, b); unpack8(*(const u32x4*)gp, g0, g1);
        float ss = (a[0] * a[0] + a[1] * a[1]) + (a[2] * a[2] + a[3] * a[3]) + (b[0] * b[0] + b[1] * b[1]) + (b[2] * b[2] + b[3] * b[3]);
        ss += __shfl_xor(ss, 1); ss += __shfl_xor(ss, 2); ss += __shfl_xor(ss, 4); ss += __shfl_xor(ss, 8);
        const float rs = __builtin_amdgcn_rsqf(ss * (1.f / 128.f) + EPS);
#pragma unroll
        for (int j = 0; j < 4; ++j) { a[j] = a[j] * rs * w0[j] * siluf_(g0[j]); b[j] = b[j] * rs * w1[j] * siluf_(g1[j]); }
        *(u32x4*)op = pack8(a, b);
    }
}


#define XB_TMO      128
#define XB_XCNT(j)  (256  + 64 * (j))
#define XB_XSUB(j)  (1280 + 64 * (j))
#define XB_XGEN(j)  (2304 + 64 * (j))
#define XB_TOP      3328
#define XB_TOPGEN   3392
#define XCD_BAR_WORDS 3456
#define XB_SPIN_CAP (1u << 22)
__device__ __forceinline__ unsigned xb_ld(unsigned* p)              { return __hip_atomic_load(p, __ATOMIC_RELAXED, __HIP_MEMORY_SCOPE_AGENT); }
__device__ __forceinline__ unsigned xb_add(unsigned* p, unsigned v) { return __hip_atomic_fetch_add(p, v, __ATOMIC_RELAXED, __HIP_MEMORY_SCOPE_AGENT); }
__device__ __forceinline__ unsigned xb_xcc_id() { return (unsigned)__builtin_amdgcn_s_getreg((3 << 11) | 20) & 0xFu; }
#define XB_SPIN(cond, bar) do { unsigned _sp = 0; while (cond) { __builtin_amdgcn_s_sleep(1); \
    if ((++_sp & 255u) == 0u) { if (xb_ld(&(bar)[XB_TMO])) break; if (_sp > XB_SPIN_CAP) { atomicAdd(&(bar)[XB_TMO], 1u); break; } } } } while (0)
struct XcdBarrier { unsigned* bar; unsigned x; volatile LAS unsigned* st; };
__device__ __forceinline__ XcdBarrier xcd_barrier_post(unsigned* bar, volatile LAS unsigned* st) {
    XcdBarrier b; b.bar = bar; b.x = xb_xcc_id(); b.st = st;
    if (threadIdx.x == 0) (void)xb_add(&bar[XB_XCNT(b.x)], 1u);
    return b;
}
__device__ __forceinline__ void xcd_barrier_complete(unsigned* bar, unsigned x, unsigned& nloc, unsigned& nx) {
    const unsigned G = gridDim.x * gridDim.y * gridDim.z;
    unsigned sum, cnt, mine, sp = 0u;
    for (;;) {
        sum = 0u; cnt = 0u; mine = 0u;
#pragma unroll
        for (unsigned j = 0; j < 16; ++j) { const unsigned c = xb_ld(&bar[XB_XCNT(j)]); sum += c; cnt += (c > 0u) ? 1u : 0u; mine = (j == x) ? c : mine; }
        if (sum == G) break;
        __builtin_amdgcn_s_sleep(1);
        if ((++sp & 255u) == 0u) { if (xb_ld(&bar[XB_TMO])) break; if (sp > XB_SPIN_CAP) { atomicAdd(&bar[XB_TMO], 1u); break; } }
    }
    nloc = mine > 0u ? mine : 1u; nx = cnt > 0u ? cnt : 1u;
}
__device__ __forceinline__ void xcd_barrier(const XcdBarrier& b) {
    asm volatile("s_waitcnt vmcnt(0)" ::: "memory");
    __syncthreads();
    if (threadIdx.x == 0) {
        unsigned* bar = b.bar;
        __builtin_amdgcn_s_waitcnt(0);
        unsigned nloc = b.st[0], nx = b.st[1];
        if (nloc == 0u) { xcd_barrier_complete(bar, b.x, nloc, nx); b.st[0] = nloc; b.st[1] = nx; }
        const unsigned old = xb_add(&bar[XB_XSUB(b.x)], 1u);
        const unsigned gen = old / nloc;
        if (old + 1u == (gen + 1u) * nloc) {
            __builtin_amdgcn_fence(__ATOMIC_RELEASE, "agent");
            asm volatile("s_waitcnt vmcnt(0)" ::: "memory");
            const unsigned og = xb_add(&bar[XB_TOP], 1u);
            const unsigned tg = og / nx;
            if (og + 1u == (tg + 1u) * nx) xb_add(&bar[XB_TOPGEN], 1u);
            else XB_SPIN(xb_ld(&bar[XB_TOPGEN]) == tg, bar);
            __builtin_amdgcn_fence(__ATOMIC_ACQUIRE, "agent");
            xb_add(&bar[XB_XGEN(b.x)], 1u);
            asm volatile("s_waitcnt vmcnt(0)" ::: "memory");
        } else {
            XB_SPIN(xb_ld(&bar[XB_XGEN(b.x)]) == gen, bar);
            __builtin_amdgcn_fence(__ATOMIC_ACQUIRE, "agent");
            asm volatile("s_waitcnt vmcnt(0)" ::: "memory");
        }
    }
    __syncthreads();
}

__global__ void __launch_bounds__(NTHREADS, 2) fwd_megakernel(Params Pkern) {
    extern __shared__ __attribute__((aligned(16))) unsigned char lds_raw[];
    LAS unsigned char* lds = (LAS unsigned char*)lds_raw;
    cg::grid_group grid = cg::this_grid();
    const int ph_lo = Pkern.ph_lo, ph_hi = Pkern.ph_hi;
    int ph = 0;
    if (threadIdx.x < 2) ((volatile LAS unsigned*)(lds + 131072))[threadIdx.x] = 0u;
    __syncthreads();
    XcdBarrier xbar; xbar.bar = (unsigned*)(Pkern.ws + WS_BAR); xbar.x = 0; xbar.st = (volatile LAS unsigned*)(lds + 131072);
#define PH_ON (ph_lo <= ph && ph < ph_hi)
#define PM(k) ((PHASE_MASK >> (k)) & 1)
#define PH_END do { if (ph_lo <= ph && ph + 1 < ph_hi) { if (ph == 0) grid.sync(); else xcd_barrier(xbar); } ++ph; } while (0)
#define WSP(off) (ws + (off))
#define SETUP KPtr Pp = kparams(); unsigned char* ws = Pp->ws; const int tid = otid(), lane = tid & 63, wid = tid >> 6; const int gw = blockIdx.x * NWAVES + wid, NGW = gridDim.x * NWAVES; \
    float* RS = (float*)WSP(WS_RS); bf16_t* wb = (bf16_t*)WSP(WS_W); bf16_t* HB = (bf16_t*)WSP(WS_HB); bf16_t* HBALT = (bf16_t*)WSP(WS_HBALT); bf16_t* PB = (bf16_t*)WSP(WS_P); bf16_t* HID = PB; \
    bf16_t* QB = (bf16_t*)WSP(WS_Q); bf16_t* KN = (bf16_t*)WSP(WS_KN); bf16_t* VT = (bf16_t*)WSP(WS_VT); bf16_t* SBVT = (bf16_t*)WSP(WS_SBVT); bf16_t* MERGED = KN; bf16_t* PBF = KN; \
    bf16_t* TMPG = PB + PC_SBK; bf16_t* TMP2 = (bf16_t*)WSP(WS_TMP2); float* ROPE = (float*)WSP(WS_ROPE); float* OUT = Pp->out; \
    (void)lane; (void)gw; (void)NGW; (void)RS; (void)wb; (void)HB; (void)HBALT; (void)HID; (void)QB; (void)KN; (void)VT; (void)SBVT; (void)MERGED; (void)PBF; (void)TMPG; (void)TMP2; (void)ROPE; (void)OUT;
#define LSETUP float* rs0 = RS + (size_t)(4 * layer) * T; float* rs1 = rs0 + T; float* rs2 = rs1 + T; float* rs3 = rs2 + T; float* rs4 = rs3 + T; \
    float* rsq = RS + (size_t)(9 + layer) * T; float* rskv = RS + (size_t)(11 + layer) * T; (void)rs0; (void)rs1; (void)rs2; (void)rs3; (void)rs4; (void)rsq; (void)rskv;

    if (PH_ON && PM(0)) for (int rep_ = 0; rep_ < ((DUPMASK & 32) ? 2 : 1); ++rep_) {
        SETUP
        convert_weights(lds, 0, 0, 16);
        convert_weights(lds, 1, 14, 16);
        for (int i = blockIdx.x * NTHREADS + tid; i < 12 * T; i += gridDim.x * NTHREADS) RS[T + i] = 0.f;
        if (blockIdx.x == 0) { unsigned* bw = (unsigned*)WSP(WS_BAR); for (int i = tid; i < XCD_BAR_WORDS; i += NTHREADS) bw[i] = 0u; }
        if (blockIdx.x == 0) { const float* lbraw = Pp->lbraw; float* lbt = (float*)WSP(WS_LBT);
            { const float l0 = lbraw[tid], l1 = lbraw[512 + tid]; float lb = 1.f / (1.f + expf(l0 - l1)); lb = fminf(fmaxf(lb, 0.f), 1.f - 1e-6f); lbt[tid] = 0.f; lbt[512 + tid] = lb; } }
        { const int* pos = Pp->pos;
          for (int i = blockIdx.x * NTHREADS + tid; i < 16 * T; i += gridDim.x * NTHREADS) { float c_, s_; rope_table_entry(pos[i >> 4], i & 15, c_, s_); ROPE[i] = c_; ROPE[(size_t)T * 16 + i] = s_; } }
        const float* X = Pp->x;
        for (int m = gw * 2; m < T; m += NGW * 2) {
            f32x4 va[2][4];
#pragma unroll
            for (int rr = 0; rr < 2; ++rr) { const f32x4* xr = (const f32x4*)(X + (size_t)(m + rr) * DM) + lane * 2;
#pragma unroll
                for (int j = 0; j < 2; ++j) { va[rr][2 * j] = xr[128 * j]; va[rr][2 * j + 1] = xr[128 * j + 1]; } }
#pragma unroll
            for (int rr = 0; rr < 2; ++rr) { float ss = 0.f;
#pragma unroll
                for (int j = 0; j < 2; ++j) { const f32x4 a = va[rr][2 * j], b = va[rr][2 * j + 1];
                    *(u32x4*)(HB + (size_t)(m + rr) * DM + 512 * j + lane * 8) = pack8(a, b);
                    ss += (a[0] * a[0] + a[1] * a[1]) + (a[2] * a[2] + a[3] * a[3]) + (b[0] * b[0] + b[1] * b[1]) + (b[2] * b[2] + b[3] * b[3]); }
#pragma unroll
                for (int o = 1; o < 64; o <<= 1) ss += __shfl_xor(ss, o);
                if (lane == 0) RS[m + rr] = ss; }
        }
    }
    PH_END;
    if (ph_hi - ph_lo > 1) xbar = xcd_barrier_post((unsigned*)(Pkern.ws + WS_BAR), (volatile LAS unsigned*)(lds + 131072));

#pragma unroll 1
    for (int layer = 0; layer < DEPTH; ++layer) {
        if (PH_ON && PM(1)) { SETUP LSETUP const bf16_t* hin = layer == 0 ? HB : HBALT; pg8::EpiSwiglu E{HID, rs0}; if (DUPMASK & 16) run_gemm(lds, hin, DM, wb + WO_A_IN, DM, T, 5632, DM, E); run_gemm(lds, hin, DM, wb + WO_A_IN, DM, T, 5632, DM, E); }
        if ((DUPMASK & 8) && ph_hi - ph_lo > 1) { xcd_barrier(xbar); xcd_barrier(xbar); xcd_barrier(xbar); xcd_barrier(xbar); xcd_barrier(xbar); }
        PH_END;
        if (PH_ON && PM(2)) for (int rep_ = ((DUPMASK & 512) ? 0 : 1); rep_ < 2; ++rep_) { SETUP LSETUP pg8::EpiResid<false> E{layer == 0 ? Pp->x : (const float*)OUT, OUT, HB, rs1, 0.5f, nullptr, nullptr, rep_ == 0}; run_gemm(lds, HID, FF, wb + WO_A_OUT, FF, T, DM, FF, E); }
        PH_END;
        if (PH_ON && PM(3)) {
            if (PM(17)) for (int rep_ = ((DUPMASK & 1024) ? 0 : 1); rep_ < 2; ++rep_) { SETUP LSETUP pg8::EpiInproj E{PB, rs1, rsq, rskv, ROPE, (const float*)WSP(WS_LBT) + layer * 512, rep_ == 0}; run_gemm(lds, HB, DM, wb + WO_IN, DM, T, 3840, DM, E); }
            if (PM(18)) { SETUP LSETUP pg8::EpiStoreCol E{SBVT, T, rs1, 1.f / 1024.f}; run_gemm(lds, wb + WO_SBV, DM, HB, DM, 512, T, DM, E); }
        }
        PH_END;
        if (PH_ON && PM(4)) {
            if (PM(12)) { SETUP const float* lbraw = Pp->lbraw; if (DUPMASK & 1) for (int u = blockIdx.x; u < 256; u += gridDim.x) hgrn_unit<true>(lds, u >> 4, (u >> 2) & 3, u & 3, layer, PB, lbraw);
              for (int u = blockIdx.x; u < 256; u += gridDim.x) hgrn_unit<false>(lds, u >> 4, (u >> 2) & 3, u & 3, layer, PB, lbraw); }
            for (int rep_ = 0; rep_ < ((DUPMASK & 128) ? 2 : 1); ++rep_) {
            if (PM(13)) { SETUP LSETUP pg8::EpiQup E{QB, rsq, ROPE}; run_gemm(lds, PB + PC_CQ, PW, wb + WO_UQ, 384, T, 768, 384, E); }
            if (PM(14)) { SETUP LSETUP pg8::EpiStore E{KN, 512, rskv, 1.f / 256.f, 0}; run_gemm(lds, PB + PC_CKV, PW, wb + WO_UK, 256, T, 512, 256, E); }
            if (PM(15)) { SETUP LSETUP pg8::EpiStoreCol E{VT, T, rskv, 1.f / 256.f}; run_gemm(lds, wb + WO_UV, 256, PB + PC_CKV, PW, 512, T, 256, E); }
            }
            if (PM(16)) { SETUP if (DUPMASK & 4) for (int u = gw; u < NBATCH * 8 * 64; u += NGW) sb_unit<true>(u >> 9, (u >> 6) & 7, u & 63, PB, SBVT);
              for (int u = gw; u < NBATCH * 8 * 64; u += NGW) sb_unit<false>(u >> 9, (u >> 6) & 7, u & 63, PB, SBVT); }
        }
        PH_END;
        if (PH_ON && PM(5)) {
            { SETUP
            for (int c = blockIdx.x; c < 256; c += gridDim.x) {
                const int bh = c >> 1;
#pragma unroll 1
                for (int i = 0; i < 4; ++i) { const int s = (c & 1) * 2 + (i >> 1); const int qb = (i & 1) ? 7 - s : s; if (DUPMASK & 2) mla_unit<true>(lds, bh >> 3, bh & 7, qb, QB, KN, PB, VT, QB); mla_unit<false>(lds, bh >> 3, bh & 7, qb, QB, KN, PB, VT, QB); }
            } }
            { SETUP hgrn_finish(PB, Pp->hg_norm + layer * 512); }
        }
        PH_END;
        if (PH_ON && PM(6)) {
#pragma unroll 1
            for (int i_ = 0; i_ < ((DUPMASK & 64) ? 6 : 3); ++i_) { const int i = i_ % 3;
                { SETUP LSETUP pg8::EpiStore E{TMPG, PW, rs1, 1.f / 1024.f, 1}; run_gemm(lds, HB, DM, wb + WO_GATE + (size_t)i * 1024 * 1024, DM, T, DM, DM, E); }
                { SETUP const bf16_t* ya = i == 0 ? QB : (i == 1 ? PB + PC_SBQ : PB + PC_HI); const int lda = i == 0 ? 768 : PW;
                  pg8::EpiBranch E{MERGED, TMPG, PW, i == 0}; run_gemm(lds, ya, lda, wb + WO_BR + (size_t)i * 1024 * 512, 512, T, DM, 512, E); }
            }
        }
        PH_END;
        if (PH_ON && PM(7)) for (int rep_ = ((DUPMASK & 2048) ? 0 : 1); rep_ < 2; ++rep_) { SETUP LSETUP pg8::EpiResid<false> E{OUT, OUT, HB, rs2, 1.0f, nullptr, nullptr, rep_ == 0}; run_gemm(lds, MERGED, DM, wb + WO_OUT, DM, T, DM, DM, E); }
        PH_END;
        if (PH_ON && PM(8)) { SETUP LSETUP pg8::EpiSwiglu E{HID, rs2}; run_gemm(lds, HB, DM, wb + WO_B_IN, DM, T, 5632, DM, E); }
        PH_END;
        if (PH_ON && PM(9)) {
            { SETUP LSETUP pg8::EpiResid<false> E{OUT, OUT, HB, rs3, 0.5f, nullptr, nullptr, 0}; run_gemm(lds, HID, FF, wb + WO_B_OUT, FF, T, DM, FF, E); }
            { SETUP const float* pp = Pp->p + (size_t)layer * T * 256;
              for (size_t i = (size_t)blockIdx.x * NTHREADS + tid; i < (size_t)T * 256 / 8; i += (size_t)gridDim.x * NTHREADS) {
                const f32x4 a = *(const f32x4*)(pp + i * 8), b = *(const f32x4*)(pp + i * 8 + 4); *(u32x4*)(PBF + i * 8) = pack8(a, b); } }
        }
        PH_END;
        if (PH_ON && PM(10)) {
            for (int rep_ = ((DUPMASK & 4096) ? 0 : 1); rep_ < 2; ++rep_) {
            if (PM(19)) { SETUP bf16_t* wple = (bf16_t*)WSP(WS_WPLE + (size_t)layer * WPLE_STRIDE); pg8::EpiStore E{TMP2, DM, nullptr, 1.f, 0}; run_gemm(lds, PBF, 256, wple + (size_t)1024 * 1024, 256, T, DM, 256, E); }
            if (PM(20)) { SETUP LSETUP bf16_t* wple = (bf16_t*)WSP(WS_WPLE + (size_t)layer * WPLE_STRIDE); pg8::EpiResid<true> E{OUT, OUT, HBALT, rs4, 1.0f, TMP2, rs3, rep_ == 0}; run_gemm(lds, HB, DM, wple, DM, T, DM, DM, E); }
            }
            if (PM(21)) if (layer + 1 < DEPTH) { __syncthreads(); convert_weights(lds, layer + 1, 0, 14); if (DUPMASK & 256) convert_weights(lds, layer + 1, 0, 14); }
        }
        PH_END;
    }
    if (PH_ON && PM(11)) {
        SETUP
        const float* rsf = RS + (size_t)8 * T; const float* fw = Pp->final_norm;
        f32x4 w[4];
#pragma unroll
        for (int j = 0; j < 4; ++j) w[j] = *((const f32x4*)fw + lane + 64 * j);
        for (int m = gw; m < T; m += NGW) {
            const float t = rstd_of(rsf[m], 1.f / 1024.f); f32x4* orow = (f32x4*)(OUT + (size_t)m * DM) + lane;
#pragma unroll
            for (int j = 0; j < 4; ++j) orow[64 * j] = orow[64 * j] * t * w[j];
        }
    }
#undef PH_ON
#undef PH_END
}

constexpr int N_PHASES = 1 + 10 * DEPTH + 1;
#ifndef MK_PER_PHASE
#define MK_PER_PHASE 0
#endif

extern "C" void kernel_launch(void* const* d_in, const int* in_sizes, int n_in, void* d_out, int out_size, void* d_ws, size_t ws_size, hipStream_t stream) {
    static int grid = 0;
    if (grid == 0) {
        if (n_in != 25 || ws_size < WS_END) { fprintf(stderr, "kernel_launch: unexpected n_in %d / ws %zu\n", n_in, ws_size); grid = -1; return; }
        int dev = 0, cus = 0, per_cu = 0;
        hipGetDevice(&dev); hipDeviceGetAttribute(&cus, hipDeviceAttributeMultiprocessorCount, dev);
        hipFuncSetAttribute((const void*)fwd_megakernel, hipFuncAttributeMaxDynamicSharedMemorySize, LDS_BYTES);
        hipOccupancyMaxActiveBlocksPerMultiprocessor(&per_cu, (const void*)fwd_megakernel, NTHREADS, LDS_BYTES);
        if (per_cu < 1) per_cu = 1;
        (void)hipGetLastError();
        grid = cus * 1;
        if (grid <= 0) grid = 256;
    }
    if (grid < 0) return;
    Params p{};
    const float** fp = (const float**)&p;
    (void)fp;
    p.x = (const float*)d_in[0]; p.p = (const float*)d_in[1]; p.pos = (const int*)d_in[2];
    p.ffn_a_norm = (const float*)d_in[3]; p.ffn_a_w_in = (const float*)d_in[4]; p.ffn_a_w_out = (const float*)d_in[5]; p.mix_norm = (const float*)d_in[6]; p.w_in = (const float*)d_in[7];
    p.mla_q_norm = (const float*)d_in[8]; p.mla_w_uq = (const float*)d_in[9]; p.mla_kv_norm = (const float*)d_in[10]; p.mla_w_ukv = (const float*)d_in[11]; p.lbraw = (const float*)d_in[12]; p.hg_norm = (const float*)d_in[13];
    p.w_br_mla = (const float*)d_in[14]; p.w_br_sb = (const float*)d_in[15]; p.w_br_hgrn = (const float*)d_in[16]; p.w_out = (const float*)d_in[17]; p.ffn_b_norm = (const float*)d_in[18]; p.ffn_b_w_in = (const float*)d_in[19]; p.ffn_b_w_out = (const float*)d_in[20];
    p.ple_norm = (const float*)d_in[21]; p.w_ple_gate = (const float*)d_in[22]; p.w_ple_proj = (const float*)d_in[23]; p.final_norm = (const float*)d_in[24];
    p.out = (float*)d_out; p.ws = (unsigned char*)d_ws;
#if MK_PER_PHASE
    for (int k = 0; k < N_PHASES; ++k) { p.ph_lo = k; p.ph_hi = k + 1; hipLaunchKernelGGL(fwd_megakernel, dim3(grid), dim3(NTHREADS), LDS_BYTES, stream, p); }
#else
    p.ph_lo = 0; p.ph_hi = N_PHASES;
    void* args[] = {&p};
    hipError_t e = hipLaunchCooperativeKernel((const void*)fwd_megakernel, dim3(grid), dim3(NTHREADS), args, LDS_BYTES, stream);
    if (e != hipSuccess) fprintf(stderr, "cooperative launch failed: %s (grid %d)\n", hipGetErrorString(e), grid);
#endif
}
```
